# Optimizing an MI355X kernel written in HIP

```python
import jax
import jax.numpy as jnp
from jax import lax
import numpy as np

D_MODEL = 2048
BATCH = 4
SEQ = 2048
DEPTH = 2

HEAD_DIM = 128
MLA_HEADS = 4
MLA_Q_RANK = 512
MLA_KV_RANK = 256
MLA_NOPE = 128
MLA_ROPE = 64
MLA_V = 128
MOBA_HEADS = 4
MOBA_BLOCK = 256
MOBA_TOPK = 3
MOBA_Q_CHUNK = 32
DIL_HEADS = 8
DIL_PATTERNS = ((128, 1), (512, 4), (2048, 16))
D_FF = 5632
ROPE_THETA = 10000.0
NORM_EPS = 1e-6
ATTN_BLOCK = 128
NEG_INF = -1e30

MLA_IN = MLA_Q_RANK + MLA_KV_RANK + MLA_ROPE
MOBA_IN = 3 * MOBA_HEADS * HEAD_DIM
DIL_IN = 3 * DIL_HEADS * HEAD_DIM
IN_WIDTH = MLA_IN + MOBA_IN + DIL_IN
MIX_WIDTH = MLA_HEADS * MLA_V + MOBA_HEADS * HEAD_DIM + DIL_HEADS * HEAD_DIM

kernel_name = 'hybrid_mla_moba_dilated_macaron'


def rms_norm(x, g):
    xf = x.astype(jnp.float32)
    y = xf * lax.rsqrt(jnp.mean(xf * xf, axis=-1, keepdims=True) + NORM_EPS)
    return (y * g.astype(jnp.float32)).astype(x.dtype)


def rope_tables(seq, dim):
    inv = ROPE_THETA ** (-jnp.arange(0, dim, 2, dtype=jnp.float32) / dim)
    ang = jnp.arange(seq, dtype=jnp.float32)[:, None] * inv[None, :]
    return jnp.cos(ang), jnp.sin(ang)


def apply_rope(x, cos, sin):
    x1, x2 = jnp.split(x, 2, axis=-1)
    c = cos.astype(x.dtype)
    s = sin.astype(x.dtype)
    return jnp.concatenate([x1 * c - x2 * s, x2 * c + x1 * s], axis=-1)


def swiglu(x, w_gate, w_up, w_down):
    return (jax.nn.silu(x @ w_gate) * (x @ w_up)) @ w_down


def split_heads(t, n_heads):
    b, s, _ = t.shape
    return t.reshape(b, s, n_heads, -1).transpose(0, 2, 1, 3)


def merge_heads(t):
    b, h, s, d = t.shape
    return t.transpose(0, 2, 1, 3).reshape(b, s, h * d)


def mla_attention(p, g_q, g_kv, w_uq, w_uk, w_uv, cos_r, sin_r):
    b, s, _ = p.shape
    c_q, c_kv, k_r = jnp.split(p, [MLA_Q_RANK, MLA_Q_RANK + MLA_KV_RANK], axis=-1)
    c_q = rms_norm(c_q, g_q)
    c_kv = rms_norm(c_kv, g_kv)
    q = split_heads(c_q @ w_uq, MLA_HEADS)
    q_nope = q[..., :MLA_NOPE]
    q_rope = apply_rope(q[..., MLA_NOPE:], cos_r, sin_r)
    k_nope = split_heads(c_kv @ w_uk, MLA_HEADS)
    v = split_heads(c_kv @ w_uv, MLA_HEADS)
    k_rope = apply_rope(k_r, cos_r, sin_r)
    scale = (MLA_NOPE + MLA_ROPE) ** -0.5
    nb = s // ATTN_BLOCK

    def to_blocks(t):
        return t.reshape(b, MLA_HEADS, nb, ATTN_BLOCK, t.shape[-1]).transpose(2, 0, 1, 3, 4)

    kpos = jnp.arange(s)

    def one_block(args):
        i, qn, qr = args
        sc = (jnp.einsum('bhqd,bhkd->bhqk', qn, k_nope)
              + jnp.einsum('bhqd,bkd->bhqk', qr, k_rope)).astype(jnp.float32) * scale
        qpos = i * ATTN_BLOCK + jnp.arange(ATTN_BLOCK)
        sc = jnp.where(kpos[None, :] <= qpos[:, None], sc, NEG_INF)
        pr = jax.nn.softmax(sc, axis=-1).astype(v.dtype)
        return jnp.einsum('bhqk,bhkd->bhqd', pr, v)

    out = lax.map(one_block, (jnp.arange(nb), to_blocks(q_nope), to_blocks(q_rope)))
    return out.transpose(1, 0, 3, 2, 4).reshape(b, s, MLA_HEADS * MLA_V)


def moba_attention(q, k, v):
    b, h, s, d = q.shape
    nblk = -(-s // MOBA_BLOCK)
    pad = nblk * MOBA_BLOCK - s
    kp = jnp.pad(k, ((0, 0), (0, 0), (0, pad), (0, 0)))
    vp = jnp.pad(v, ((0, 0), (0, 0), (0, pad), (0, 0)))
    kb = kp.reshape(b, h, nblk, MOBA_BLOCK, d)
    vb = vp.reshape(b, h, nblk, MOBA_BLOCK, d)
    k_mean = jnp.mean(kb.astype(jnp.float32), axis=3)
    topk = min(MOBA_TOPK, nblk - 1)
    scale = d ** -0.5
    nq = s // MOBA_Q_CHUNK
    q_chunks = q.reshape(b, h, nq, MOBA_Q_CHUNK, d).transpose(2, 0, 1, 3, 4)
    blk_ids = jnp.arange(nblk)
    take_blocks = jax.vmap(jax.vmap(lambda blocks, idx: blocks[idx]))

    def one_chunk(args):
        i, qi = args
        q0 = i * MOBA_Q_CHUNK
        own = q0 // MOBA_BLOCK
        qpos = q0 + jnp.arange(MOBA_Q_CHUNK)
        k_own = lax.dynamic_slice_in_dim(kp, own * MOBA_BLOCK, MOBA_BLOCK, axis=2)
        v_own = lax.dynamic_slice_in_dim(vp, own * MOBA_BLOCK, MOBA_BLOCK, axis=2)
        kpos = own * MOBA_BLOCK + jnp.arange(MOBA_BLOCK)
        s_own = jnp.einsum('bhqd,bhkd->bhqk', qi, k_own).astype(jnp.float32) * scale
        s_own = jnp.where(kpos[None, :] <= qpos[:, None], s_own, NEG_INF)
        if topk == 0:
            pr = jax.nn.softmax(s_own, axis=-1).astype(v.dtype)
            return jnp.einsum('bhqk,bhkd->bhqd', pr, v_own)
        gate = jnp.einsum('bhqd,bhnd->bhqn', qi.astype(jnp.float32), k_mean)
        gate = jnp.where(blk_ids < own, gate, NEG_INF)
        _, idx = lax.top_k(gate, topk)
        valid = idx < own
        k_sel = take_blocks(kb, idx)
        v_sel = take_blocks(vb, idx)
        s_sel = jnp.einsum('bhqd,bhqnkd->bhqnk', qi, k_sel).astype(jnp.float32) * scale
        n_sel = topk * MOBA_BLOCK
        s_sel = jnp.where(valid[..., None], s_sel, NEG_INF).reshape(b, h, MOBA_Q_CHUNK, n_sel)
        pr = jax.nn.softmax(jnp.concatenate([s_sel, s_own], axis=-1), axis=-1).astype(v.dtype)
        return (jnp.einsum('bhqk,bhqkd->bhqd', pr[..., :n_sel],
                           v_sel.reshape(b, h, MOBA_Q_CHUNK, n_sel, d))
                + jnp.einsum('bhqk,bhkd->bhqd', pr[..., n_sel:], v_own))

    out = lax.map(one_chunk, (jnp.arange(nq), q_chunks))
    return out.transpose(1, 2, 0, 3, 4).reshape(b, h, s, d)


def dilated_attention(q, k, v):
    b, h, s, d = q.shape
    scale = d ** -0.5
    ms, dens, accs = [], [], []
    for window, dil in DIL_PATTERNS:
        n = window // dil
        sub_len = s // dil
        nb = -(-sub_len // n)
        lp = nb * n

        def to_sub(t):
            t = t.reshape(b, h, sub_len, dil, d).transpose(0, 1, 3, 2, 4)
            t = jnp.pad(t, ((0, 0), (0, 0), (0, 0), (0, lp - sub_len), (0, 0)))
            return t.reshape(b, h, dil, nb, n, d)

        def band(t):
            prev = jnp.pad(t, ((0, 0), (0, 0), (0, 0), (1, 0), (0, 0), (0, 0)))[:, :, :, :-1]
            return jnp.concatenate([prev, t], axis=4)

        qs = to_sub(q)
        kband = band(to_sub(k))
        vband = band(to_sub(v))
        sc = jnp.einsum('bhrnqd,bhrnkd->bhrnqk', qs, kband).astype(jnp.float32) * scale
        qi = jnp.arange(n)[:, None]
        kj = jnp.arange(2 * n)[None, :]
        dist = qi + n - kj
        key_idx = jnp.arange(nb)[:, None, None] * n - n + kj[None]
        mask = (dist >= 0) & (dist <= n) & (key_idx >= 0)
        sc = jnp.where(mask, sc, NEG_INF)
        m = jnp.max(sc, axis=-1, keepdims=True)
        e = jnp.exp(sc - m)
        den = jnp.sum(e, axis=-1, keepdims=True)
        acc = jnp.einsum('bhrnqk,bhrnkd->bhrnqd', e, vband.astype(jnp.float32))

        def from_sub(t):
            last = t.shape[-1]
            t = t.reshape(b, h, dil, lp, last)[:, :, :, :sub_len]
            return t.transpose(0, 1, 3, 2, 4).reshape(b, h, s, last)

        ms.append(from_sub(m))
        dens.append(from_sub(den))
        accs.append(from_sub(acc))
    m_all = jnp.max(jnp.stack(ms, axis=0), axis=0)
    num = sum(jnp.exp(mp - m_all) * ap for mp, ap in zip(ms, accs))
    tot = sum(jnp.exp(mp - m_all) * dp for mp, dp in zip(ms, dens))
    return (num / tot).astype(q.dtype)


def hybrid_layer(x, ln_ffn1, w_ffn1_gate, w_ffn1_up, w_ffn1_down, ln_mix, w_in,
                 g_mla_q, g_mla_kv, w_mla_uq, w_mla_uk, w_mla_uv, w_out,
                 ln_ffn2, w_ffn2_gate, w_ffn2_up, w_ffn2_down,
                 cos_h, sin_h, cos_r, sin_r):
    x = x + 0.5 * swiglu(rms_norm(x, ln_ffn1), w_ffn1_gate, w_ffn1_up, w_ffn1_down)
    hmix = rms_norm(x, ln_mix)
    proj = hmix @ w_in
    p_mla, p_moba, p_dil = jnp.split(proj, [MLA_IN, MLA_IN + MOBA_IN], axis=-1)
    o_mla = mla_attention(p_mla, g_mla_q, g_mla_kv, w_mla_uq, w_mla_uk, w_mla_uv, cos_r, sin_r)
    q, k, v = (split_heads(t, MOBA_HEADS) for t in jnp.split(p_moba, 3, axis=-1))
    o_moba = merge_heads(moba_attention(apply_rope(q, cos_h, sin_h), apply_rope(k, cos_h, sin_h), v))
    q, k, v = (split_heads(t, DIL_HEADS) for t in jnp.split(p_dil, 3, axis=-1))
    o_dil = merge_heads(dilated_attention(apply_rope(q, cos_h, sin_h), apply_rope(k, cos_h, sin_h), v))
    x = x + jnp.concatenate([o_mla, o_moba, o_dil], axis=-1) @ w_out
    x = x + 0.5 * swiglu(rms_norm(x, ln_ffn2), w_ffn2_gate, w_ffn2_up, w_ffn2_down)
    return x


def setup_inputs(seed: int = 0) -> dict:
    key = jax.random.key(seed)
    ks = jax.random.split(key, 18)

    def w(k, shape, fan_in):
        return jax.random.normal(k, shape, jnp.float32) * (fan_in ** -0.5)

    def g(k, shape):
        return 1.0 + 0.02 * jax.random.normal(k, shape, jnp.float32)

    return {
        'x': jax.random.normal(ks[0], (BATCH, SEQ, D_MODEL), jnp.float32),
        'ln_ffn1': g(ks[1], (DEPTH, D_MODEL)),
        'w_ffn1_gate': w(ks[2], (DEPTH, D_MODEL, D_FF), D_MODEL),
        'w_ffn1_up': w(ks[3], (DEPTH, D_MODEL, D_FF), D_MODEL),
        'w_ffn1_down': w(ks[4], (DEPTH, D_FF, D_MODEL), D_FF),
        'ln_mix': g(ks[5], (DEPTH, D_MODEL)),
        'w_in': w(ks[6], (DEPTH, D_MODEL, IN_WIDTH), D_MODEL),
        'g_mla_q': g(ks[7], (DEPTH, MLA_Q_RANK)),
        'g_mla_kv': g(ks[8], (DEPTH, MLA_KV_RANK)),
        'w_mla_uq': w(ks[9], (DEPTH, MLA_Q_RANK, MLA_HEADS * (MLA_NOPE + MLA_ROPE)), MLA_Q_RANK),
        'w_mla_uk': w(ks[10], (DEPTH, MLA_KV_RANK, MLA_HEADS * MLA_NOPE), MLA_KV_RANK),
        'w_mla_uv': w(ks[11], (DEPTH, MLA_KV_RANK, MLA_HEADS * MLA_V), MLA_KV_RANK),
        'w_out': w(ks[12], (DEPTH, MIX_WIDTH, D_MODEL), MIX_WIDTH),
        'ln_ffn2': g(ks[13], (DEPTH, D_MODEL)),
        'w_ffn2_gate': w(ks[14], (DEPTH, D_MODEL, D_FF), D_MODEL),
        'w_ffn2_up': w(ks[15], (DEPTH, D_MODEL, D_FF), D_MODEL),
        'w_ffn2_down': w(ks[16], (DEPTH, D_FF, D_MODEL), D_FF),
        'ln_final': g(ks[17], (D_MODEL,)),
    }


def reference(x, ln_ffn1, w_ffn1_gate, w_ffn1_up, w_ffn1_down, ln_mix, w_in,
              g_mla_q, g_mla_kv, w_mla_uq, w_mla_uk, w_mla_uv, w_out,
              ln_ffn2, w_ffn2_gate, w_ffn2_up, w_ffn2_down, ln_final):
    s = x.shape[1]
    cos_h, sin_h = rope_tables(s, HEAD_DIM)
    cos_r, sin_r = rope_tables(s, MLA_ROPE)
    for l in range(DEPTH):
        x = hybrid_layer(x, ln_ffn1[l], w_ffn1_gate[l], w_ffn1_up[l], w_ffn1_down[l],
                         ln_mix[l], w_in[l], g_mla_q[l], g_mla_kv[l],
                         w_mla_uq[l], w_mla_uk[l], w_mla_uv[l], w_out[l],
                         ln_ffn2[l], w_ffn2_gate[l], w_ffn2_up[l], w_ffn2_down[l],
                         cos_h, sin_h, cos_r, sin_r)
    return rms_norm(x, ln_final)
```

```cpp
#define MK_COOP 1
#include <hip/hip_runtime.h>
namespace pg8 {
#define PG8_LAS __attribute__((address_space(3)))
typedef unsigned short bf16_t;
typedef short bf16x8 __attribute__((ext_vector_type(8)));
typedef float f32x4 __attribute__((ext_vector_type(4)));
typedef unsigned u32x4 __attribute__((ext_vector_type(4)));
constexpr int BM = 256, BK = 64, HALF = 128, HTB = HALF * BK * 2  , STAGE_BYTES = 8 * HTB, NXCD = 8, WGM = 8;

__host__ __device__ __forceinline__ int lds_byte(int r, int c) { const int st = (r >> 4) * 2 + (c >> 5), rr = r & 15, cc = c & 31, ob = rr * 64 + cc * 2; return st * 1024 + (ob ^ (((ob >> 9) & 1) << 5)); }
__host__ __device__ __forceinline__ void stage_rc(int b, int& R, int& C) { const int st = b / 1024, sb = b % 1024, swz = sb ^ (((sb >> 9) & 1) << 5); R = (st >> 1) * 16 + swz / 64; C = (st & 1) * 32 + (swz % 64) / 2; }
__host__ __device__ __forceinline__ int perm32(int rho) { const int n = rho >> 4, i = rho & 15; return 8 * (i >> 2) + 4 * n + (i & 3); }

struct Unit { int pm, pn; };
struct Gemm { const bf16_t* A; const bf16_t* Bt; int M, N, K, lda; };

struct StaticOrder {
    int nM, nN, nwg, G, c;
    __host__ __device__ void init(int M, int N, int G_, int c_) { nM = M / BM; nN = N / BM; nwg = nM * nN; G = G_; c = c_; }
    __host__ __device__ bool next(int i, Unit& u) const {
        const long L = (long)i * G + c; if (L >= nwg) return false;
        int wgid = (int)L; { const int q = nwg / NXCD, r = nwg % NXCD, xcd = wgid % NXCD, off = wgid / NXCD; wgid = (xcd < r ? xcd * (q + 1) : r * (q + 1) + (xcd - r) * q) + off; }
        const int nig = WGM * nN, gid = wgid / nig, fm = gid * WGM, gsz = (nM - fm) < WGM ? (nM - fm) : WGM;
        u.pm = fm + ((wgid % nig) % gsz); u.pn = (wgid % nig) / gsz; return true;
    }
    __device__ __forceinline__ void a_ready(const Unit&) const {}
    __device__ __forceinline__ void done(const Unit&) const {}
};
__device__ __forceinline__ unsigned cvt_pk_bf16(float lo, float hi) { unsigned r; asm volatile("v_cvt_pk_bf16_f32 %0, %1, %2" : "=v"(r) : "v"(lo), "v"(hi)); return r; }
typedef float f32x2 __attribute__((ext_vector_type(2)));
typedef unsigned u32x2 __attribute__((ext_vector_type(2)));
__device__ __forceinline__ float silu_f(float g) { return g * __builtin_amdgcn_rcpf(1.0f + __builtin_amdgcn_exp2f(-1.4426950408889634f * g)); }
__device__ __forceinline__ void atomic_addf(float* p, float v) { (void)__hip_atomic_fetch_add(p, v, __ATOMIC_RELAXED, __HIP_MEMORY_SCOPE_AGENT); }
__device__ __forceinline__ float row_rstd(const float* ss, int row, float invd) { return 1.0f / sqrtf(ss[row] * invd + 1e-6f); }
struct EpiSwiglu {
    static constexpr bool PERM = true, AFTER_DRAIN = false, INIT = false, PRE = true;
    bf16_t* H; int ldh; const float* ss; float invd;
    __device__ __forceinline__ void pre(float (&p)[8], const Unit& u, int wr, int fr) const {
#pragma unroll
        for (int i = 0; i < 8; ++i) p[i] = ss[u.pm * BM + wr * 64 + fr + (i >> 2) * HALF + (i & 3) * 16];
    }
    __device__ __forceinline__ void operator()(const f32x4 (&acc)[2][2][4][2], const Unit& u, int wr, int wc, int fr, int fq, const float (&p)[8]) const {
        const int row0 = u.pm * BM + wr * 64 + fr, col0 = u.pn * HALF + wc * 32 + 8 * fq;
#pragma unroll
        for (int ai = 0; ai < 2; ++ai)
#pragma unroll
            for (int m = 0; m < 4; ++m) {
                const int row = row0 + ai * HALF + m * 16;
                const float rs = 1.0f / sqrtf(p[ai * 4 + m] * invd + 1e-6f);
                bf16_t* rowp = H + (size_t)row * ldh + col0;
                const f32x4 g0 = acc[ai][0][m][0] * rs, g1 = acc[ai][0][m][1] * rs, u0 = acc[ai][1][m][0] * rs, u1 = acc[ai][1][m][1] * rs;
                u32x4 w;
                w.x = cvt_pk_bf16(silu_f(g0[0]) * u0[0], silu_f(g0[1]) * u0[1]); w.y = cvt_pk_bf16(silu_f(g0[2]) * u0[2], silu_f(g0[3]) * u0[3]);
                w.z = cvt_pk_bf16(silu_f(g1[0]) * u1[0], silu_f(g1[1]) * u1[1]); w.w = cvt_pk_bf16(silu_f(g1[2]) * u1[2], silu_f(g1[3]) * u1[3]);
                *(u32x4*)rowp = w;
            }
    }
};
struct EpiResid {
    static constexpr bool PERM = true, AFTER_DRAIN = false, INIT = true, PRE = false;
    const float* src; float* dst; bf16_t* xb; float* ss; int ld; float scale, rscale;
    __device__ __forceinline__ void init(f32x4 (&acc)[2][2][4][2], const Unit& u, int wr, int wc, int fr, int fq) const {
        const int row0 = u.pm * BM + wr * 64 + fr, col0 = u.pn * BM + wc * 32 + 8 * fq;
#pragma unroll
        for (int ai = 0; ai < 2; ++ai)
#pragma unroll
            for (int m = 0; m < 4; ++m) {
                const size_t off = (size_t)(row0 + ai * HALF + m * 16) * ld + col0;
#pragma unroll
                for (int bj = 0; bj < 2; ++bj) { acc[ai][bj][m][0] = *(const f32x4*)(src + off + bj * HALF) * rscale; acc[ai][bj][m][1] = *(const f32x4*)(src + off + bj * HALF + 4) * rscale; }
            }
    }
    __device__ __forceinline__ void operator()(const f32x4 (&acc)[2][2][4][2], const Unit& u, int wr, int wc, int fr, int fq) const {
        const int row0 = u.pm * BM + wr * 64 + fr, col0 = u.pn * BM + wc * 32 + 8 * fq;
#pragma unroll
        for (int ai = 0; ai < 2; ++ai)
#pragma unroll
            for (int m = 0; m < 4; ++m) {
                const int row = row0 + ai * HALF + m * 16;
                const size_t off = (size_t)row * ld + col0;
                float sq = 0.f;
#pragma unroll
                for (int bj = 0; bj < 2; ++bj) {
                    const size_t o = off + bj * HALF;
                    const f32x4 y0 = acc[ai][bj][m][0] * scale, y1 = acc[ai][bj][m][1] * scale;
                    *(f32x4*)(dst + o) = y0; *(f32x4*)(dst + o + 4) = y1;
                    sq += (y0[0] * y0[0] + y0[1] * y0[1]) + (y0[2] * y0[2] + y0[3] * y0[3]) + (y1[0] * y1[0] + y1[1] * y1[1]) + (y1[2] * y1[2] + y1[3] * y1[3]);
                    u32x4 w; w.x = cvt_pk_bf16(y0[0], y0[1]); w.y = cvt_pk_bf16(y0[2], y0[3]); w.z = cvt_pk_bf16(y1[0], y1[1]); w.w = cvt_pk_bf16(y1[2], y1[3]);
                    *(u32x4*)(xb + o) = w;
                }
                sq += __shfl_xor(sq, 16); sq += __shfl_xor(sq, 32);
                if (fq == 0) atomic_addf(ss + row, sq);
            }
    }
};
template <bool WIN> struct EpiProj {
    static constexpr bool PERM = true, AFTER_DRAIN = false, INIT = false, PRE = false;
    bf16_t* O; int ldc; int r64lo, r64hi, r32t; const float* cos64; const float* sin64; const float* cos32; const float* sin32;
    const float* ss; float invd; float* ssq; float* sskv; float* ksum;
    __device__ __forceinline__ void operator()(const f32x4 (&acc)[2][2][4][2], const Unit& u, int wr, int wc, int fr, int fq) const {
        const int row0 = u.pm * BM + wr * 64 + fr;
        const bool rope64 = (u.pn >= r64lo && u.pn < r64hi), rope32 = (u.pn == r32t);
        if (rope64 || rope32) {
            const int RH = rope64 ? 64 : 32;
            const int hh = rope64 ? (wc >> 1) : wc;
            const int j0 = rope64 ? (32 * (wc & 1) + 8 * fq) : 8 * fq;
            const int colb = u.pn * BM + 2 * RH * hh + j0;
            const float* cT = rope64 ? cos64 : cos32; const float* sT = rope64 ? sin64 : sin32;
            f32x4 k0 = {0.f, 0.f, 0.f, 0.f}, k1 = k0, k2 = k0, k3 = k0;
#pragma unroll
            for (int ai = 0; ai < 2; ++ai)
#pragma unroll
                for (int m = 0; m < 4; ++m) {
                    const int row = row0 + ai * HALF + m * 16, pos = row & 2047;
                    const float rs = row_rstd(ss, row, invd);
                    const f32x4 c0 = *(const f32x4*)(cT + pos * RH + j0), c1 = *(const f32x4*)(cT + pos * RH + j0 + 4);
                    const f32x4 s0 = *(const f32x4*)(sT + pos * RH + j0), s1 = *(const f32x4*)(sT + pos * RH + j0 + 4);
                    const f32x4 xa = acc[ai][0][m][0] * rs, xb = acc[ai][0][m][1] * rs, ya = acc[ai][1][m][0] * rs, yb = acc[ai][1][m][1] * rs;
                    const f32x4 pa = xa * c0 - ya * s0, pb = xb * c1 - yb * s1, qa = ya * c0 + xa * s0, qb = yb * c1 + xb * s1;
                    bf16_t* rowp = O + (size_t)row * ldc + colb;
                    u32x4 w; w.x = cvt_pk_bf16(pa[0], pa[1]); w.y = cvt_pk_bf16(pa[2], pa[3]); w.z = cvt_pk_bf16(pb[0], pb[1]); w.w = cvt_pk_bf16(pb[2], pb[3]);
                    *(u32x4*)rowp = w;
                    u32x4 v; v.x = cvt_pk_bf16(qa[0], qa[1]); v.y = cvt_pk_bf16(qa[2], qa[3]); v.z = cvt_pk_bf16(qb[0], qb[1]); v.w = cvt_pk_bf16(qb[2], qb[3]);
                    *(u32x4*)(rowp + RH) = v;
                    if (WIN) { k0 += pa; k1 += pb; k2 += qa; k3 += qb; }
                }
            if (WIN && (u.pn == 2 || u.pn == 3)) {
#pragma unroll
                for (int e = 0; e < 4; ++e)
#pragma unroll
                    for (int o = 1; o < 16; o <<= 1) { k0[e] += __shfl_xor(k0[e], o); k1[e] += __shfl_xor(k1[e], o); k2[e] += __shfl_xor(k2[e], o); k3[e] += __shfl_xor(k3[e], o); }
                if (fr == 0) {
                    float* kp = ksum + ((size_t)(((u.pm >> 3) * 4 + 2 * (u.pn - 2) + hh) * 8 + (u.pm & 7))) * 128 + j0;
#pragma unroll
                    for (int e = 0; e < 4; ++e) { atomic_addf(kp + e, k0[e]); atomic_addf(kp + 4 + e, k1[e]); atomic_addf(kp + 64 + e, k2[e]); atomic_addf(kp + 68 + e, k3[e]); }
                }
            }
        } else {
            const int col0 = u.pn * BM + wc * 32 + 8 * fq;
            float* sqdst = nullptr;
            if (WIN) sqdst = (u.pn == 18 || u.pn == 19) ? ssq : (u.pn == 20) ? sskv : nullptr;
#pragma unroll
            for (int ai = 0; ai < 2; ++ai)
#pragma unroll
                for (int m = 0; m < 4; ++m) {
                    const int row = row0 + ai * HALF + m * 16;
                    const float rs = row_rstd(ss, row, invd);
                    bf16_t* rowp = O + (size_t)row * ldc + col0;
                    float sq = 0.f;
#pragma unroll
                    for (int bj = 0; bj < 2; ++bj) { const f32x4 v0 = acc[ai][bj][m][0] * rs, v1 = acc[ai][bj][m][1] * rs;
                        if (WIN) sq += (v0[0] * v0[0] + v0[1] * v0[1]) + (v0[2] * v0[2] + v0[3] * v0[3]) + (v1[0] * v1[0] + v1[1] * v1[1]) + (v1[2] * v1[2] + v1[3] * v1[3]);
                        u32x4 w; w.x = cvt_pk_bf16(v0[0], v0[1]); w.y = cvt_pk_bf16(v0[2], v0[3]); w.z = cvt_pk_bf16(v1[0], v1[1]); w.w = cvt_pk_bf16(v1[2], v1[3]);
                        *(u32x4*)(rowp + bj * HALF) = w; }
                    if (WIN && sqdst) { sq += __shfl_xor(sq, 16); sq += __shfl_xor(sq, 32); if (fq == 0) atomic_addf(sqdst + row, sq); }
                }
        }
    }
};
template <class Epi, class Sched, bool ALIGN_EPI = false, bool SP2 = false>
__device__ __forceinline__ void gemm_phase(PG8_LAS unsigned char* lds, const Gemm g, const Sched& S, const Epi& E) {
    int tid_l = threadIdx.x; asm volatile("" : "+v"(tid_l)); const int tid = tid_l, wid = __builtin_amdgcn_readfirstlane(tid >> 6), lane = tid & 63, wr = wid >> 2, wc = wid & 3, fr = lane & 15, fq = lane >> 4;
    const int K = g.K, nt = K / BK;
    unsigned voffA[2], voffB[2];
#pragma unroll
    for (int i = 0; i < 2; ++i) { int R, C; stage_rc(tid * 16 + i * 8192, R, C); const int Rb = Epi::PERM ? ((R & ~31) + perm32(R & 31)) : R;
        voffA[i] = (unsigned)(R * g.lda + C) * 2u; voffB[i] = (unsigned)(Rb * K + C) * 2u; }
    const size_t kstep = (size_t)(BK * 2);
    const size_t hstep = (size_t)HALF * K * 2, hstepA = (size_t)HALF * g.lda * 2;
    const size_t tstep = 2 * hstep, tstepA = 2 * hstepA;
    const unsigned ldsw = (unsigned)wid * 1024u;
    const int aoff = lds_byte(wr * 64 + fr, fq * 8), boff = lds_byte(wc * 32 + fr, fq * 8);
#define PG8_SA(b, h) (((b) * 2 + (h)) * HTB)
#define PG8_SB(b, h) ((4 + (b) * 2 + (h)) * HTB)
#define PG8_STAGE(bufoff, gbase, voff) do { _Pragma("unroll") for (int _i = 0; _i < 2; ++_i) \
        __builtin_amdgcn_global_load_lds((const unsigned*)((const char*)(gbase) + (voff)[_i]), (PG8_LAS unsigned*)(lds + (bufoff) + ldsw + _i * 8192), 16, 0, 0); } while (0)
#define PG8_LDA(dst, b, h) do { _Pragma("unroll") for (int m = 0; m < 4; ++m) _Pragma("unroll") for (int k = 0; k < 2; ++k) dst[m][k] = *(const PG8_LAS bf16x8*)(lds + PG8_SA(b, h) + aoff + m * 2048 + k * 1024); } while (0)
#define PG8_LDB(dst, b, h) do { _Pragma("unroll") for (int n = 0; n < 2; ++n) _Pragma("unroll") for (int k = 0; k < 2; ++k) dst[n][k] = *(const PG8_LAS bf16x8*)(lds + PG8_SB(b, h) + boff + n * 2048 + k * 1024); } while (0)
#define PG8_MMA(ai, bj, At, Bt) do { __builtin_amdgcn_s_setprio(1); _Pragma("unroll") for (int m = 0; m < 4; ++m) _Pragma("unroll") for (int n = 0; n < 2; ++n) _Pragma("unroll") for (int k = 0; k < 2; ++k) \
        acc[ai][bj][m][n] = __builtin_amdgcn_mfma_f32_16x16x32_bf16(Bt[n][k], At[m][k], acc[ai][bj][m][n], 0, 0, 0); __builtin_amdgcn_s_setprio(0); } while (0)
#define PG8_WAIT_V(n) asm volatile("s_waitcnt vmcnt(" #n ")" ::: "memory")
#define PG8_WAIT_L(n) asm volatile("s_waitcnt lgkmcnt(" #n ")" ::: "memory")
#define PG8_BAR __builtin_amdgcn_s_barrier()
#define PG8_SCHED __builtin_amdgcn_sched_barrier(0)
    Unit cur, nxt; int ui = 0;
    if (!S.next(0, cur)) return;
    f32x4 acc[2][2][4][2];
    if constexpr (Epi::INIT) E.init(acc, cur, wr, wc, fr, fq);
    else {
#pragma unroll
    for (int a = 0; a < 2; ++a)
#pragma unroll
        for (int b = 0; b < 2; ++b)
#pragma unroll
            for (int m = 0; m < 4; ++m)
#pragma unroll
                for (int n = 0; n < 2; ++n) acc[a][b][m][n] = (f32x4){0.f, 0.f, 0.f, 0.f};
    }
    float pre[8];
    if constexpr (Epi::PRE) E.pre(pre, cur, wr, fr);
    bf16x8 At[4][2], B0[2][2], B1[2][2];
    const char* cA = (const char*)g.A + (size_t)cur.pm * tstepA; const char* cB = (const char*)g.Bt + (size_t)cur.pn * tstep;
    S.a_ready(cur);
    if constexpr (SP2) {
        PG8_STAGE(PG8_SB(0, 0), cB, voffB); PG8_STAGE(PG8_SB(0, 1), cB + hstep, voffB); PG8_STAGE(PG8_SA(0, 0), cA, voffA); PG8_STAGE(PG8_SA(0, 1), cA + hstepA, voffA);
        if (wr == 1) PG8_BAR;
        PG8_WAIT_V(2); PG8_BAR;
        PG8_STAGE(PG8_SB(1, 0), cB + kstep, voffB); PG8_STAGE(PG8_SA(1, 0), cA + kstep, voffA); PG8_STAGE(PG8_SB(1, 1), cB + hstep + kstep, voffB);
        PG8_WAIT_V(6); PG8_BAR;
    } else {
        PG8_STAGE(PG8_SB(0, 0), cB, voffB); PG8_STAGE(PG8_SA(0, 0), cA, voffA); PG8_STAGE(PG8_SB(0, 1), cB + hstep, voffB); PG8_STAGE(PG8_SA(0, 1), cA + hstepA, voffA);
        if (wr == 1) PG8_BAR;
        PG8_WAIT_V(4); PG8_BAR;
        PG8_STAGE(PG8_SB(1, 0), cB + kstep, voffB); PG8_STAGE(PG8_SA(1, 0), cA + kstep, voffA); PG8_STAGE(PG8_SB(1, 1), cB + hstep + kstep, voffB);
        PG8_WAIT_V(6); PG8_BAR;
    }
    for (;;) {
        const bool has_next = S.next(ui + 1, nxt);
        const char* nA = has_next ? (const char*)g.A + (size_t)nxt.pm * tstepA : cA; const char* nB = has_next ? (const char*)g.Bt + (size_t)nxt.pn * tstep : cB;
        for (int t = 0; t < nt; t += 2) {
            const bool last = (t == nt - 2);
            const char* a1 = cA + (size_t)(t + 1) * kstep;
            const char* a2 = last ? nA : cA + (size_t)(t + 2) * kstep; const char* b2 = last ? nB : cB + (size_t)(t + 2) * kstep;
            const char* a3 = a2 + kstep; const char* b3 = b2 + kstep;
            if (last && has_next) S.a_ready(nxt);
            if constexpr (SP2) {
            PG8_LDB(B0, 0, 0); PG8_LDB(B1, 0, 1); PG8_SCHED; PG8_LDA(At, 0, 0); PG8_STAGE(PG8_SA(1, 1), a1 + hstepA, voffA);
            PG8_WAIT_V(8); PG8_WAIT_L(0); PG8_BAR; PG8_MMA(0, 0, At, B0); PG8_MMA(0, 1, At, B1); PG8_BAR; PG8_SCHED;
            PG8_LDA(At, 0, 1); PG8_STAGE(PG8_SB(0, 0), b2, voffB); PG8_STAGE(PG8_SB(0, 1), b2 + hstep, voffB); PG8_STAGE(PG8_SA(0, 0), a2, voffA);
            PG8_WAIT_V(8); PG8_WAIT_L(0); PG8_BAR; PG8_MMA(1, 0, At, B0); PG8_MMA(1, 1, At, B1); PG8_BAR; PG8_SCHED;
            PG8_LDB(B0, 1, 0); PG8_LDB(B1, 1, 1); PG8_SCHED; PG8_LDA(At, 1, 0); PG8_STAGE(PG8_SA(0, 1), a2 + hstepA, voffA);
            PG8_WAIT_V(8); PG8_WAIT_L(0); PG8_BAR; PG8_MMA(0, 0, At, B0); PG8_MMA(0, 1, At, B1); PG8_BAR; PG8_SCHED;
            PG8_LDA(At, 1, 1); PG8_STAGE(PG8_SB(1, 0), b3, voffB); PG8_STAGE(PG8_SB(1, 1), b3 + hstep, voffB); PG8_STAGE(PG8_SA(1, 0), a3, voffA);
            PG8_WAIT_V(8); PG8_WAIT_L(0); PG8_BAR; PG8_MMA(1, 0, At, B0); PG8_MMA(1, 1, At, B1); PG8_BAR; PG8_SCHED;
            } else {
            PG8_LDB(B0, 0, 0); PG8_SCHED; PG8_LDA(At, 0, 0); PG8_STAGE(PG8_SA(1, 1), a1 + hstepA, voffA);
            PG8_WAIT_L(8); PG8_BAR; PG8_WAIT_L(0); PG8_MMA(0, 0, At, B0); PG8_BAR; PG8_SCHED;
            PG8_LDB(B1, 0, 1); PG8_STAGE(PG8_SB(0, 0), b2, voffB);
            PG8_BAR; PG8_WAIT_L(0); PG8_MMA(0, 1, At, B1); PG8_BAR;
            PG8_LDA(At, 0, 1); PG8_STAGE(PG8_SA(0, 0), a2, voffA);
            PG8_BAR; PG8_WAIT_L(0); PG8_MMA(1, 0, At, B0); PG8_BAR; PG8_SCHED;
            PG8_STAGE(PG8_SB(0, 1), b2 + hstep, voffB);
            PG8_WAIT_V(6); PG8_BAR; PG8_MMA(1, 1, At, B1); PG8_BAR;
            PG8_LDB(B0, 1, 0); PG8_SCHED; PG8_LDA(At, 1, 0); PG8_STAGE(PG8_SA(0, 1), a2 + hstepA, voffA);
            PG8_WAIT_L(8); PG8_BAR; PG8_WAIT_L(0); PG8_MMA(0, 0, At, B0); PG8_BAR; PG8_SCHED;
            PG8_LDB(B1, 1, 1); PG8_STAGE(PG8_SB(1, 0), b3, voffB);
            PG8_BAR; PG8_WAIT_L(0); PG8_MMA(0, 1, At, B1); PG8_BAR;
            PG8_LDA(At, 1, 1); PG8_STAGE(PG8_SA(1, 0), a3, voffA);
            PG8_BAR; PG8_WAIT_L(0); PG8_MMA(1, 0, At, B0); PG8_BAR; PG8_SCHED;
            PG8_STAGE(PG8_SB(1, 1), b3 + hstep, voffB);
            PG8_WAIT_V(6); PG8_BAR; PG8_MMA(1, 1, At, B1); PG8_BAR;
            }
        }
        if constexpr (ALIGN_EPI) { if (wr == 0) PG8_BAR; }
        if constexpr (!Epi::AFTER_DRAIN) { if constexpr (Epi::PRE) E(acc, cur, wr, wc, fr, fq, pre); else E(acc, cur, wr, wc, fr, fq); S.done(cur); }
        if (!has_next) break;
        if constexpr (Epi::PRE) E.pre(pre, nxt, wr, fr);
        if constexpr (Epi::INIT) E.init(acc, nxt, wr, wc, fr, fq);
        else {
#pragma unroll
        for (int a = 0; a < 2; ++a)
#pragma unroll
            for (int b = 0; b < 2; ++b)
#pragma unroll
                for (int m = 0; m < 4; ++m)
#pragma unroll
                    for (int n = 0; n < 2; ++n) acc[a][b][m][n] = (f32x4){0.f, 0.f, 0.f, 0.f};
        }
        cur = nxt; cA = nA; cB = nB; ++ui;
        if constexpr (ALIGN_EPI) { if (wr == 1) PG8_BAR; }
    }
    PG8_WAIT_V(0);
    if constexpr (!ALIGN_EPI) { if (wr == 0) PG8_BAR; }
    PG8_BAR;
    if constexpr (Epi::AFTER_DRAIN) { E.fused(acc, cur, wr, wc, fr, fq, lds, wid, lane); S.done(cur); }
#undef PG8_SA
#undef PG8_SB
#undef PG8_STAGE
#undef PG8_LDA
#undef PG8_LDB
#undef PG8_MMA
#undef PG8_WAIT_V
#undef PG8_WAIT_L
#undef PG8_BAR
#undef PG8_SCHED
}
}

#include <hip/hip_cooperative_groups.h>
#include <cstdio>
#include <cstdint>
namespace cg = cooperative_groups;
#ifndef EN_G1
#define EN_G1 1
#endif
#ifndef EN_G2
#define EN_G2 1
#endif
#ifndef EN_G3
#define EN_G3 1
#endif
#ifndef EN_G4
#define EN_G4 1
#endif
#ifndef EN_A0
#define EN_A0 1
#endif
#ifndef EN_A1
#define EN_A1 1
#endif
#ifndef EN_A2
#define EN_A2 1
#endif
#ifndef MK_COOP
#define MK_COOP 1
#endif
#define LAS __attribute__((address_space(3)))
typedef unsigned short bf16;
typedef short bf16x8 __attribute__((ext_vector_type(8)));
typedef short s16x4 __attribute__((ext_vector_type(4)));
typedef float f32x4 __attribute__((ext_vector_type(4)));
typedef float f32x16 __attribute__((ext_vector_type(16)));
typedef unsigned u32x4 __attribute__((ext_vector_type(4)));
typedef unsigned u32x2 __attribute__((ext_vector_type(2)));

constexpr int NWAVES = 8, NTHR = 512;
constexpr int SEQ = 2048, DM = 2048, MROWS = 8192, DFF = 5632, DEPTH = 2;
constexpr int NPROJ = 5632;
constexpr int IN_W = 5440;
constexpr float EPS = 1e-6f;
constexpr int NPHASE = 2 + 8 * DEPTH;
constexpr int PQ_MOBA = 0, PK_MOBA = 512, PQ_DIL = 1024, PK_DIL = 2048, PV_MOBA = 3072, PV_DIL = 3584, P_CQ = 4608, P_CKV = 5120, P_KR = 5376;

constexpr size_t SZ_GU = (size_t)2 * DFF * DM * 2, SZ_D = (size_t)DM * DFF * 2, SZ_IN = (size_t)NPROJ * DM * 2, SZ_UQ = (size_t)768 * 512 * 2, SZ_UKV = (size_t)1024 * 256 * 2, SZ_OUT = (size_t)DM * DM * 2;
constexpr size_t WO_GU1 = 0, WO_D1 = WO_GU1 + SZ_GU, WO_IN = WO_D1 + SZ_D, WO_UQ = WO_IN + SZ_IN, WO_UKV = WO_UQ + SZ_UQ, WO_OUT = WO_UKV + SZ_UKV, WO_GU2 = WO_OUT + SZ_OUT, WO_D2 = WO_GU2 + SZ_GU, W_LAYER = WO_D2 + SZ_D;
constexpr size_t WS_W = 0;
constexpr size_t WS_X = WS_W + DEPTH * W_LAYER;
constexpr size_t WS_XB = WS_X + (size_t)MROWS * DM * 4;
constexpr size_t WS_HP = WS_XB + (size_t)MROWS * DM * 2;
constexpr size_t WS_CAT = WS_HP + (size_t)MROWS * NPROJ * 2;
constexpr size_t WS_QM = WS_CAT + (size_t)MROWS * DM * 2;
constexpr size_t WS_KV = WS_QM + (size_t)MROWS * 768 * 2;
constexpr size_t WS_STAT = WS_KV + (size_t)MROWS * 1024 * 2;
constexpr int ST_SS = 0, ST_SSQ = 7 * MROWS, ST_SSKV = 9 * MROWS, ST_KSUM = 11 * MROWS, ST_WQ = 11 * MROWS + 2 * 16384  , ST_TOTAL = ST_WQ + 128;
constexpr size_t WS_TAB = WS_STAT + (size_t)ST_TOTAL * 4;
constexpr size_t WS_BAR = WS_TAB + (size_t)2048 * (64 + 64 + 32 + 32) * 4;
constexpr size_t BAR_BYTES = 16384;
constexpr size_t WS_END = WS_BAR + BAR_BYTES;
constexpr int LDS_BYTES = 147456;

__device__ __forceinline__ float wave_sum(float v) {
#pragma unroll
    for (int o = 1; o < 64; o <<= 1) v += __shfl_xor(v, o);
    return v;
}
__device__ __forceinline__ unsigned f2bf(float f) { unsigned u = __builtin_bit_cast(unsigned, f); return (u + 0x7fffu + ((u >> 16) & 1u)) >> 16; }
__device__ __forceinline__ unsigned pk2(float lo, float hi) { return f2bf(lo) | (f2bf(hi) << 16); }
__device__ __forceinline__ float bf2f(short v) { return __uint_as_float(((unsigned)(unsigned short)v) << 16); }
#define LDS_WAIT() asm volatile("s_waitcnt lgkmcnt(0)" ::: "memory")

__device__ __forceinline__ void conv_item(const float* Wc  , int NS, int K, bf16* WT  , const float* gk  , int lane) {
    const int r = lane >> 3, c = lane & 7;
    f32x4 v[16];
    if (Wc) {
#pragma unroll
        for (int i = 0; i < 16; ++i) { const int k = (i < 8) ? 8 * r + i : 64 + 8 * r + (i - 8); v[i] = __builtin_nontemporal_load((const f32x4*)(Wc + (size_t)k * NS + 4 * c)); }
        if (gk) {
#pragma unroll
            for (int hf = 0; hf < 2; ++hf) { const f32x4 g0 = *(const f32x4*)(gk + 64 * hf + 8 * r), g1 = *(const f32x4*)(gk + 64 * hf + 8 * r + 4);
                v[8 * hf + 0] *= g0.x; v[8 * hf + 1] *= g0.y; v[8 * hf + 2] *= g0.z; v[8 * hf + 3] *= g0.w; v[8 * hf + 4] *= g1.x; v[8 * hf + 5] *= g1.y; v[8 * hf + 6] *= g1.z; v[8 * hf + 7] *= g1.w; }
        }
    } else {
#pragma unroll
        for (int i = 0; i < 16; ++i) v[i] = (f32x4){0.f, 0.f, 0.f, 0.f};
    }
#pragma unroll
    for (int e = 0; e < 4; ++e)
#pragma unroll
        for (int hf = 0; hf < 2; ++hf) {
            u32x4 o; o.x = pk2(v[8 * hf + 0][e], v[8 * hf + 1][e]); o.y = pk2(v[8 * hf + 2][e], v[8 * hf + 3][e]); o.z = pk2(v[8 * hf + 4][e], v[8 * hf + 5][e]); o.w = pk2(v[8 * hf + 6][e], v[8 * hf + 7][e]);
            *(u32x4*)(WT + (size_t)(4 * c + e) * K + 64 * hf + 8 * r) = o;
        }
}
__device__ __forceinline__ int win_srccol(int n0) {
    const int t = n0 >> 8, w = n0 & 255, bj = w >> 7, c = w & 127;
    if (t < 12) { const int base = t < 2 ? 832 + 256 * t : t < 4 ? 1344 + 256 * (t - 2) : t < 8 ? 2368 + 256 * (t - 4) : 3392 + 256 * (t - 8); return base + 128 * (c >> 6) + 64 * bj + (c & 63); }
    if (t < 14) return 1856 + 256 * (t - 12) + w;
    if (t < 18) return 4416 + 256 * (t - 14) + w;
    if (t < 20) return 256 * (t - 18) + w;
    if (t == 20) return 512 + w;
    return c < 32 ? 768 + 32 * bj + c : -1;
}
constexpr int IT_GU = (DM / 128) * (2 * DFF / 32), IT_D = (DFF / 128) * (DM / 32), IT_IN = (DM / 128) * (NPROJ / 32), IT_UQ = (512 / 128) * (768 / 32), IT_UKV = (256 / 128) * (1024 / 32), IT_OUT = (DM / 128) * (DM / 32);
constexpr int IT_LAYER = 2 * IT_GU + 2 * IT_D + IT_IN + IT_UQ + IT_UKV + IT_OUT;

__device__ __forceinline__ void sincos_d(double x, float& s, float& c) {
    const double kq = __builtin_rint(x * 0.63661977236758134308);
    const int q = ((int)kq) & 3;
    double r = __builtin_fma(-kq, 1.57079632679489655800e+00, x); r = __builtin_fma(-kq, 6.12323399573676603587e-17, r);
    const double r2 = r * r;
    double sp = -1.0 / 1307674368000.0; sp = sp * r2 + 1.0 / 6227020800.0; sp = sp * r2 - 1.0 / 39916800.0; sp = sp * r2 + 1.0 / 362880.0; sp = sp * r2 - 1.0 / 5040.0; sp = sp * r2 + 1.0 / 120.0; sp = sp * r2 - 1.0 / 6.0;
    const double sn = r + r * r2 * sp;
    double cp = 1.0 / 20922789888000.0; cp = cp * r2 - 1.0 / 87178291200.0; cp = cp * r2 + 1.0 / 479001600.0; cp = cp * r2 - 1.0 / 3628800.0; cp = cp * r2 + 1.0 / 40320.0; cp = cp * r2 - 1.0 / 720.0; cp = cp * r2 + 1.0 / 24.0; cp = cp * r2 - 0.5;
    const double cs = 1.0 + r2 * cp;
    const double so = (q == 0) ? sn : (q == 1) ? cs : (q == 2) ? -sn : -cs;
    const double co = (q == 0) ? cs : (q == 1) ? -sn : (q == 2) ? -cs : sn;
    s = (float)so; c = (float)co;
}

constexpr int ATT_KOFF = 0, ATT_VOFF = 64 * 400, ATT_VP = 320, ATT_BUF = ATT_VOFF + 64 * ATT_VP, ATT_KMOFF = 2 * ATT_BUF;
#define MFMA32(a, b, c) __builtin_amdgcn_mfma_f32_32x32x16_bf16((a), (b), (c), 0, 0, 0)
#define SCHED_FENCE() __builtin_amdgcn_sched_barrier(0)
constexpr float ATT_THR = 8.0f;
typedef short v4i16_t __attribute__((ext_vector_type(4)));
__device__ __forceinline__ s16x4 vtr(const LAS unsigned char* p) { return __builtin_bit_cast(s16x4, __builtin_amdgcn_ds_read_tr16_b64_v4i16((LAS v4i16_t*)p)); }
typedef float f32x2_t __attribute__((ext_vector_type(2))); typedef __bf16 bf16x2_t __attribute__((ext_vector_type(2)));
__device__ __forceinline__ unsigned cvtpk(float lo, float hi) { f32x2_t v = {lo, hi}; bf16x2_t b = __builtin_convertvector(v, bf16x2_t); return __builtin_bit_cast(unsigned, b); }
__device__ __forceinline__ float dil_lw(int d) {
    if (d < 0) return -INFINITY;
    const int w = (d <= 128 ? 1 : 0) + ((((d & 3) == 0) && d <= 512) ? 1 : 0) + (((d & 15) == 0) ? 1 : 0);
    return w == 0 ? -INFINITY : w == 1 ? 0.f : w == 2 ? 1.f : 1.5849625007211562f;
}
__device__ __forceinline__ float max3(float a, float b, float c) { return fmaxf(fmaxf(a, b), c); }

template <int DQK, int MODE>
__device__ __forceinline__ void attn_unit(LAS unsigned char* lds, int qb, int b,
        const bf16* Q1, int ldq1, const bf16* Q2, int ldq2, const bf16* K1, int ldk1, const bf16* K2, int ldk2,
        const bf16* V, int ldv, bf16* O, int ldo, float sc, const float* kmean) {
    constexpr int NKS = DQK / 16, KP = DQK * 2 + 16, KB = 2, NBT = NKS / KB;
    int tid_l = threadIdx.x; asm volatile("" : "+v"(tid_l));
    const int tid = tid_l, lane = tid & 63, wid = __builtin_amdgcn_readfirstlane(tid >> 6), r32 = lane & 31, h = lane >> 5;
    const int q0w = qb * 256 + wid * 32, qp = q0w + r32;
    const size_t rowb = (size_t)b * SEQ;
    bf16x8 qf[NKS];
#pragma unroll
    for (int ks = 0; ks < NKS; ++ks) { const int d = 16 * ks + 8 * h;
        qf[ks] = (ks < 8) ? *(const bf16x8*)(Q1 + (rowb + qp) * ldq1 + d) : *(const bf16x8*)(Q2 + (rowb + qp) * ldq2 + (d - 128)); }
    unsigned sel = 0u;
    __syncthreads();
    if (MODE == 1) {
        if (qb <= 3) sel = (1u << qb) - 1u;
        else {
            LAS float* km = (LAS float*)(lds + ATT_KMOFF);
            for (int i = tid; i < 1024; i += NTHR) km[i] = kmean[i];
            __syncthreads();
            float g[7];
#pragma unroll
            for (int k = 0; k < 7; ++k) g[k] = 0.f;
#pragma unroll
            for (int dc = 0; dc < 8; ++dc) {
                const bf16x8 qv = *(const bf16x8*)(Q1 + (rowb + qp) * ldq1 + 64 * h + 8 * dc);
                float qx[8];
#pragma unroll
                for (int e = 0; e < 8; ++e) qx[e] = bf2f(qv[e]);
#pragma unroll
                for (int k = 0; k < 7; ++k) { const f32x4 a = *(const LAS f32x4*)(km + k * 128 + 64 * h + 8 * dc), c = *(const LAS f32x4*)(km + k * 128 + 64 * h + 8 * dc + 4);
                    g[k] += (qx[0] * a.x + qx[1] * a.y) + (qx[2] * a.z + qx[3] * a.w) + (qx[4] * c.x + qx[5] * c.y) + (qx[6] * c.z + qx[7] * c.w); }
            }
#pragma unroll
            for (int k = 0; k < 7; ++k) g[k] += __shfl_xor(g[k], 32);
#pragma unroll
            for (int r = 0; r < 3; ++r) { float best = -INFINITY; int bi = -1;
#pragma unroll
                for (int k = 0; k < 7; ++k) if (k < qb && !((sel >> k) & 1u) && g[k] > best) { best = g[k]; bi = k; }
                if (bi >= 0) sel |= 1u << bi; }
        }
    }
    float fl[16];
    if (MODE == 2) {
#pragma unroll
        for (int i = 0; i < 16; ++i) fl[i] = (((qp - 4 * h - ((i & 3) + 8 * (i >> 2))) & 15) == 0) ? 0.f : -INFINITY;
    }
    LAS float* dtab = (LAS float*)(lds + ATT_KMOFF + 4096);
    if (MODE == 2) { for (int i = tid; i < 2144; i += NTHR) dtab[i] = dil_lw(i - 96); }
    const int NT = 4 * (qb + 1);
    f32x16 o[4];
#pragma unroll
    for (int i = 0; i < 4; ++i) o[i] = (f32x16){0.f, 0.f, 0.f, 0.f, 0.f, 0.f, 0.f, 0.f, 0.f, 0.f, 0.f, 0.f, 0.f, 0.f, 0.f, 0.f};
    float mrun = -1e30f, lrun = 0.f;
    u32x4 kr0, kr1, kr2, vr0, vr1;
    const int srow0 = tid >> 4, sch = tid & 15, srow1 = srow0 + 32, rrow = tid >> 3, rch = tid & 7;
#define ATT_LOAD(t) do { const size_t kb_ = rowb + (size_t)(t) * 64; \
        kr0 = *(const u32x4*)(K1 + (kb_ + srow0) * ldk1 + 8 * sch); kr1 = *(const u32x4*)(K1 + (kb_ + srow1) * ldk1 + 8 * sch); \
        if (DQK == 192) kr2 = *(const u32x4*)(K2 + (kb_ + rrow) * ldk2 + 8 * rch); \
        vr0 = *(const u32x4*)(V + (kb_ + srow0) * ldv + 8 * sch); vr1 = *(const u32x4*)(V + (kb_ + srow1) * ldv + 8 * sch); } while (0)
#define ATT_STORE(bo) do { *(LAS u32x4*)(lds + (bo) + ATT_KOFF + srow0 * KP + 16 * sch) = kr0; *(LAS u32x4*)(lds + (bo) + ATT_KOFF + srow1 * KP + 16 * sch) = kr1; \
        if (DQK == 192) *(LAS u32x4*)(lds + (bo) + ATT_KOFF + rrow * KP + 256 + 16 * rch) = kr2; \
        *(LAS u32x4*)(lds + (bo) + ATT_VOFF + srow0 * ATT_VP + 16 * sch) = vr0; *(LAS u32x4*)(lds + (bo) + ATT_VOFF + srow1 * ATT_VP + 16 * sch) = vr1; } while (0)
    const LAS unsigned char* kbase = lds + ATT_KOFF + r32 * KP + 16 * h;
    const int i16 = lane & 15;
    const LAS unsigned char* vbase = lds + ATT_VOFF + (4 * h + (i16 >> 2)) * ATT_VP + (16 * ((lane >> 4) & 1) + 4 * (i16 & 3)) * 2;
    ATT_LOAD(0);
    ATT_STORE(0);
    ATT_LOAD(1);
    __syncthreads();
    for (int t = 0; t < NT; ++t) {
        const int bo = (t & 1) * ATT_BUF;
        bool act = (64 * t <= q0w + 31);
        bool allowed = true;
        const bool own = (MODE != 1) || ((t >> 2) == qb);
        if (MODE == 1 && !own) { allowed = ((sel >> (t >> 2)) & 1u) != 0u; act = act && (__ballot(allowed) != 0ull); }
        if (act) {
            const f32x16 z16 = (f32x16){0.f, 0.f, 0.f, 0.f, 0.f, 0.f, 0.f, 0.f, 0.f, 0.f, 0.f, 0.f, 0.f, 0.f, 0.f, 0.f};
            f32x16 s0 = z16, s1 = z16;
            const LAS unsigned char* kb = kbase + bo;
            bf16x8 ka[2][KB][2];
#pragma unroll
            for (int j = 0; j < KB; ++j) { ka[0][j][0] = *(const LAS bf16x8*)(kb + 32 * j); ka[0][j][1] = *(const LAS bf16x8*)(kb + 32 * KP + 32 * j); }
#pragma unroll
            for (int bt = 0; bt < NBT; ++bt) {
                if (bt + 1 < NBT) {
#pragma unroll
                    for (int j = 0; j < KB; ++j) { ka[(bt + 1) & 1][j][0] = *(const LAS bf16x8*)(kb + 32 * (KB * (bt + 1) + j)); ka[(bt + 1) & 1][j][1] = *(const LAS bf16x8*)(kb + 32 * KP + 32 * (KB * (bt + 1) + j)); }
                }
                SCHED_FENCE();
#pragma unroll
                for (int j = 0; j < KB; ++j) { s0 = MFMA32(ka[bt & 1][j][0], qf[KB * bt + j], s0); s1 = MFMA32(ka[bt & 1][j][1], qf[KB * bt + j], s1); }
                SCHED_FENCE();
            }
            const LAS unsigned char* vb = vbase + bo;
            s16x4 vf[2][4][2];
#pragma unroll
            for (int kk = 0; kk < 4; ++kk) { vf[0][kk][0] = vtr(vb + (16 * kk) * ATT_VP); vf[0][kk][1] = vtr(vb + (16 * kk + 8) * ATT_VP); }
            SCHED_FENCE();
            const int kp_base = 64 * t + 4 * h;
            const bool diag = (64 * t + 63 > q0w);
            float mnew;
            if (MODE == 2) {
                if (q0w - (64 * t + 63) > 512) {
#pragma unroll
                    for (int i = 0; i < 16; ++i) { s0[i] = __builtin_fmaf(s0[i], sc, fl[i]); s1[i] = __builtin_fmaf(s1[i], sc, fl[i]); }
                } else {
                    const LAS float* tp = dtab + (qp - 64 * t - 4 * h + 37);
#pragma unroll
                    for (int i = 0; i < 16; ++i) { const int ci = (i & 3) + 8 * (i >> 2);
                        s0[i] = __builtin_fmaf(s0[i], sc, tp[59 - ci]); s1[i] = __builtin_fmaf(s1[i], sc, tp[27 - ci]); }
                }
                float ma = max3(s0[0], s0[1], s1[0]), mb = max3(s0[2], s0[3], s1[1]); ma = max3(ma, s1[2], s1[3]);
#pragma unroll
                for (int i = 4; i < 16; i += 4) { ma = max3(ma, s0[i], s0[i + 1]); mb = max3(mb, s0[i + 2], s0[i + 3]); ma = max3(ma, s1[i], s1[i + 1]); mb = max3(mb, s1[i + 2], s1[i + 3]); }
                float mx = fmaxf(ma, mb); { const auto rr_ = __builtin_amdgcn_permlane32_swap(__float_as_uint(mx), __float_as_uint(mx), false, false); mx = fmaxf(__uint_as_float(rr_[0]), __uint_as_float(rr_[1])); }
                mnew = (__ballot(mx - mrun > ATT_THR) != 0ull) ? fmaxf(mrun, mx) : mrun;
#pragma unroll
                for (int i = 0; i < 16; ++i) { s0[i] = __builtin_amdgcn_exp2f(s0[i] - mnew); s1[i] = __builtin_amdgcn_exp2f(s1[i] - mnew); }
            } else {
                if (own && diag) {
#pragma unroll
                    for (int i = 0; i < 16; ++i) { const int kp0 = kp_base + (i & 3) + 8 * (i >> 2); if (kp0 > qp) s0[i] = -INFINITY; if (kp0 + 32 > qp) s1[i] = -INFINITY; }
                }
                if (MODE == 1 && !allowed) {
#pragma unroll
                    for (int i = 0; i < 16; ++i) { s0[i] = -INFINITY; s1[i] = -INFINITY; }
                }
                float ma = max3(s0[0], s0[1], s1[0]), mb = max3(s0[2], s0[3], s1[1]); ma = max3(ma, s1[2], s1[3]);
#pragma unroll
                for (int i = 4; i < 16; i += 4) { ma = max3(ma, s0[i], s0[i + 1]); mb = max3(mb, s0[i + 2], s0[i + 3]); ma = max3(ma, s1[i], s1[i + 1]); mb = max3(mb, s1[i + 2], s1[i + 3]); }
                float mx = fmaxf(ma, mb) * sc; { const auto rr_ = __builtin_amdgcn_permlane32_swap(__float_as_uint(mx), __float_as_uint(mx), false, false); mx = fmaxf(__uint_as_float(rr_[0]), __uint_as_float(rr_[1])); }
                mnew = (__ballot(mx - mrun > ATT_THR) != 0ull) ? fmaxf(mrun, mx) : mrun;
                const float nm = -mnew;
#pragma unroll
                for (int i = 0; i < 16; ++i) { s0[i] = __builtin_amdgcn_exp2f(__builtin_fmaf(s0[i], sc, nm)); s1[i] = __builtin_amdgcn_exp2f(__builtin_fmaf(s1[i], sc, nm)); }
            }
            float la = 0.f, lb = 0.f;
#pragma unroll
            for (int i = 0; i < 16; i += 2) { la += s0[i] + s1[i]; lb += s0[i + 1] + s1[i + 1]; }
            const float alpha = __builtin_amdgcn_exp2f(mrun - mnew);
            lrun = lrun * alpha + (la + lb);
            if (__ballot(mnew > mrun) != 0ull) {
#pragma unroll
                for (int db = 0; db < 4; ++db)
#pragma unroll
                    for (int i = 0; i < 16; ++i) o[db][i] *= alpha;
            }
            mrun = mnew;
            bf16x8 pf[2][2];
#pragma unroll
            for (int s = 0; s < 2; ++s) {
                u32x4 w0, w1;
                w0.x = cvtpk(s0[8 * s + 0], s0[8 * s + 1]); w0.y = cvtpk(s0[8 * s + 2], s0[8 * s + 3]); w0.z = cvtpk(s0[8 * s + 4], s0[8 * s + 5]); w0.w = cvtpk(s0[8 * s + 6], s0[8 * s + 7]);
                w1.x = cvtpk(s1[8 * s + 0], s1[8 * s + 1]); w1.y = cvtpk(s1[8 * s + 2], s1[8 * s + 3]); w1.z = cvtpk(s1[8 * s + 4], s1[8 * s + 5]); w1.w = cvtpk(s1[8 * s + 6], s1[8 * s + 7]);
                pf[0][s] = __builtin_bit_cast(bf16x8, w0); pf[1][s] = __builtin_bit_cast(bf16x8, w1);
            }
#pragma unroll
            for (int db = 0; db < 4; ++db) {
                if (db + 1 < 4) {
#pragma unroll
                    for (int kk = 0; kk < 4; ++kk) { vf[(db + 1) & 1][kk][0] = vtr(vb + (16 * kk) * ATT_VP + 64 * (db + 1)); vf[(db + 1) & 1][kk][1] = vtr(vb + (16 * kk + 8) * ATT_VP + 64 * (db + 1)); }
                }
                SCHED_FENCE();
#pragma unroll
                for (int kk = 0; kk < 4; ++kk) {
                    const s16x4 lo = vf[db & 1][kk][0], hi = vf[db & 1][kk][1];
                    const bf16x8 vv = (bf16x8){lo[0], lo[1], lo[2], lo[3], hi[0], hi[1], hi[2], hi[3]};
                    o[db] = MFMA32(vv, pf[kk >> 1][kk & 1], o[db]);
                }
                SCHED_FENCE();
            }
        }
        if (t + 1 < NT) { ATT_STORE(((t + 1) & 1) * ATT_BUF); if (t + 2 < NT) ATT_LOAD(t + 2); }
        __syncthreads();
    }
#undef ATT_LOAD
#undef ATT_STORE
    lrun += __shfl_xor(lrun, 32);
    const float inv = 1.0f / lrun;
    bf16* orow = O + (rowb + qp) * ldo + 8 * h;
#pragma unroll
    for (int db = 0; db < 4; ++db)
#pragma unroll
        for (int gp = 0; gp < 2; ++gp) {
            const int ge = 8 * gp, go = 8 * gp + 4;
            const unsigned x0 = cvtpk(o[db][ge + 0] * inv, o[db][ge + 1] * inv), x1 = cvtpk(o[db][ge + 2] * inv, o[db][ge + 3] * inv);
            const unsigned y0 = cvtpk(o[db][go + 0] * inv, o[db][go + 1] * inv), y1 = cvtpk(o[db][go + 2] * inv, o[db][go + 3] * inv);
            const auto sa = __builtin_amdgcn_permlane32_swap(x0, y0, false, false);
            const auto sb = __builtin_amdgcn_permlane32_swap(x1, y1, false, false);
            u32x4 w; w.x = sa[0]; w.y = sb[0]; w.z = sa[1]; w.w = sb[1];
            *(u32x4*)(orow + 32 * db + 16 * gp) = w;
        }
}

constexpr int O_GU1 = 0, O_D1 = O_GU1 + IT_GU, O_IN = O_D1 + IT_D, O_UQ = O_IN + IT_IN, O_UKV = O_UQ + IT_UQ, O_OUT = O_UKV + IT_UKV, O_GU2 = O_OUT + IT_OUT, O_D2 = O_GU2 + IT_GU;
static_assert(O_D2 + IT_D == IT_LAYER, "item list");
constexpr int CUTB = O_D2, CUT1 = CUTB + 2816, CUT2 = CUT1 + 2385, CUT3 = CUT2 + 6084, CUT4 = CUT3 + 6800, CUT5 = IT_LAYER + O_D2, CUTE = 2 * IT_LAYER;
static_assert(CUT1 >= IT_LAYER && CUT3 >= IT_LAYER + O_IN && CUT4 >= IT_LAYER + O_GU2 && CUT4 <= CUT5 && CUT5 == IT_LAYER + O_D2, "every matrix is copied before the phase that reads it");
struct Args;
__device__ __forceinline__ void convert_items(const float* const* in, unsigned char* ws, int lo, int hi, int rank, int nrank, int lane) {
    for (int it = lo + rank; it < hi; it += nrank) {
        const int l = it / IT_LAYER; int r = it - l * IT_LAYER;
        unsigned char* wl = ws + WS_W + (size_t)l * W_LAYER;
        const float* src; int NS, K, ND; bf16* dst; int kind;
        const float* src2 = nullptr; const float* gain = nullptr;
        if (r < IT_GU) { src = in[2] + (size_t)l * DM * DFF; src2 = in[3] + (size_t)l * DM * DFF; NS = DFF; K = DM; ND = 2 * DFF; dst = (bf16*)(wl + WO_GU1); kind = 1; gain = in[1] + (size_t)l * DM; }
        else if ((r -= IT_GU) < IT_D) { src = in[4] + (size_t)l * DFF * DM; NS = DM; K = DFF; ND = DM; dst = (bf16*)(wl + WO_D1); kind = 0; }
        else if ((r -= IT_D) < IT_IN) { src = in[6] + (size_t)l * DM * IN_W; NS = IN_W; K = DM; ND = NPROJ; dst = (bf16*)(wl + WO_IN); kind = 2; gain = in[5] + (size_t)l * DM; }
        else if ((r -= IT_IN) < IT_UQ) { src = in[9] + (size_t)l * 512 * 768; NS = 768; K = 512; ND = 768; dst = (bf16*)(wl + WO_UQ); kind = 3; gain = in[7] + (size_t)l * 512; }
        else if ((r -= IT_UQ) < IT_UKV) { src = in[10] + (size_t)l * 256 * 512; src2 = in[11] + (size_t)l * 256 * 512; NS = 512; K = 256; ND = 1024; dst = (bf16*)(wl + WO_UKV); kind = 4; gain = in[8] + (size_t)l * 256; }
        else if ((r -= IT_UKV) < IT_OUT) { src = in[12] + (size_t)l * DM * DM; NS = DM; K = DM; ND = DM; dst = (bf16*)(wl + WO_OUT); kind = 0; }
        else if ((r -= IT_OUT) < IT_GU) { src = in[14] + (size_t)l * DM * DFF; src2 = in[15] + (size_t)l * DM * DFF; NS = DFF; K = DM; ND = 2 * DFF; dst = (bf16*)(wl + WO_GU2); kind = 1; gain = in[13] + (size_t)l * DM; }
        else { r -= IT_GU; src = in[16] + (size_t)l * DFF * DM; NS = DM; K = DFF; ND = DM; dst = (bf16*)(wl + WO_D2); kind = 0; }
        const int nblk = ND / 32, kb = r / nblk, nb = r - kb * nblk, k0 = 128 * kb, n0 = 32 * nb;
        int sc_;
        if (kind == 0) sc_ = n0;
        else if (kind == 1) { const int t = n0 >> 8, bj = (n0 >> 7) & 1, c = n0 & 127; sc_ = 128 * t + c; if (bj) src = src2; }
        else if (kind == 2) sc_ = win_srccol(n0);
        else if (kind == 3) { if (n0 < 512) sc_ = (n0 >> 7) * 192 + (n0 & 127); else { const int w = n0 - 512, bj = w >> 7, c = w & 127; sc_ = (c >> 5) * 192 + 128 + 32 * bj; } }
        else { if (n0 < 512) sc_ = n0; else { sc_ = n0 - 512; src = src2; } }
        conv_item(sc_ >= 0 ? src + (size_t)k0 * NS + sc_ : nullptr, NS, K, dst + (size_t)n0 * K + k0, gain ? gain + k0 : nullptr, lane);
    }
}

#define XB_TMO      128
#define XB_XCNT(j)  (256  + 64 * (j))
#define XB_XSUB(j)  (1280 + 64 * (j))
#define XB_XGEN(j)  (2304 + 64 * (j))
#define XB_TOP      3328
#define XB_TOPGEN   3392
#define XCD_BAR_WORDS 3456
#define XB_SPIN_CAP (1u << 18)

__device__ __forceinline__ unsigned xb_ld(unsigned* p)              { return __hip_atomic_load(p, __ATOMIC_RELAXED, __HIP_MEMORY_SCOPE_AGENT); }
__device__ __forceinline__ unsigned xb_add(unsigned* p, unsigned v) { return __hip_atomic_fetch_add(p, v, __ATOMIC_RELAXED, __HIP_MEMORY_SCOPE_AGENT); }
__device__ __forceinline__ unsigned xb_xcc_id() { return (unsigned)__builtin_amdgcn_s_getreg((3 << 11) | 20) & 0xFu; }
#define XB_SPIN(cond, bar) do { unsigned _sp = 0; while (cond) { __builtin_amdgcn_s_sleep(1); \
    if ((++_sp & 255u) == 0u) { if (xb_ld(&(bar)[XB_TMO])) break; if (_sp > XB_SPIN_CAP) { atomicAdd(&(bar)[XB_TMO], 1u); break; } } } } while (0)

struct XcdBarrier {
    unsigned* bar; unsigned x;
    volatile LAS unsigned* st;
};

__device__ __forceinline__ XcdBarrier xcd_barrier_post(unsigned* bar, volatile LAS unsigned* st) {
    XcdBarrier b; b.bar = bar; b.x = xb_xcc_id(); b.st = st;
    if (threadIdx.x == 0) (void)xb_add(&bar[XB_XCNT(b.x)], 1u);
    return b;
}
__device__ __forceinline__ void xcd_barrier_complete(unsigned* bar, unsigned x, unsigned& nloc, unsigned& nx) {
    const unsigned G = gridDim.x * gridDim.y * gridDim.z;
    unsigned sum, cnt, mine, sp = 0u;
    for (;;) {
        sum = 0u; cnt = 0u; mine = 0u;
#pragma unroll
        for (unsigned j = 0; j < 16; ++j) { const unsigned c = xb_ld(&bar[XB_XCNT(j)]); sum += c; cnt += (c > 0u) ? 1u : 0u; mine = (j == x) ? c : mine; }
        if (sum == G) break;
        __builtin_amdgcn_s_sleep(1);
        if ((++sp & 255u) == 0u) { if (xb_ld(&bar[XB_TMO])) break; if (sp > XB_SPIN_CAP) { atomicAdd(&bar[XB_TMO], 1u); break; } }
    }
    nloc = mine > 0u ? mine : 1u; nx = cnt > 0u ? cnt : 1u;
}

__device__ __forceinline__ void xcd_barrier(const XcdBarrier& b) {
    asm volatile("s_waitcnt vmcnt(0)" ::: "memory");
    __syncthreads();
    if (threadIdx.x == 0) {
        unsigned* bar = b.bar;
        __builtin_amdgcn_s_waitcnt(0);
        unsigned nloc = b.st[0], nx = b.st[1];
        if (nloc == 0u) { xcd_barrier_complete(bar, b.x, nloc, nx); b.st[0] = nloc; b.st[1] = nx; }
        const unsigned old = xb_add(&bar[XB_XSUB(b.x)], 1u);
        const unsigned gen = old / nloc;
        if (old + 1u == (gen + 1u) * nloc) {
            __builtin_amdgcn_fence(__ATOMIC_RELEASE, "agent");
            asm volatile("s_waitcnt vmcnt(0)" ::: "memory");
            const unsigned og = xb_add(&bar[XB_TOP], 1u);
            const unsigned tg = og / nx;
            if (og + 1u == (tg + 1u) * nx) xb_add(&bar[XB_TOPGEN], 1u);
            else XB_SPIN(xb_ld(&bar[XB_TOPGEN]) == tg, bar);
            __builtin_amdgcn_fence(__ATOMIC_ACQUIRE, "agent");
            xb_add(&bar[XB_XGEN(b.x)], 1u);
            asm volatile("s_waitcnt vmcnt(0)" ::: "memory");
        } else {
            XB_SPIN(xb_ld(&bar[XB_XGEN(b.x)]) == gen, bar);
            __builtin_amdgcn_fence(__ATOMIC_ACQUIRE, "agent");
            asm volatile("s_waitcnt vmcnt(0)" ::: "memory");
        }
    }
    __syncthreads();
}

struct Args { const float* in[18]; float* out; unsigned char* ws; int ph_lo, ph_hi; };
template <int PH> __device__ __forceinline__ void run_phase(const Args& args, LAS unsigned char* lds) {
    const int G = gridDim.x, bid = blockIdx.x, NGW = G * NWAVES;
    unsigned char* ws = args.ws;
    float* X = (float*)(ws + WS_X); bf16* XB = (bf16*)(ws + WS_XB); bf16* HP = (bf16*)(ws + WS_HP); bf16* CAT = (bf16*)(ws + WS_CAT);
    bf16* QM = (bf16*)(ws + WS_QM); bf16* KV = (bf16*)(ws + WS_KV);
    float* STAT = (float*)(ws + WS_STAT);
    float* COSH = (float*)(ws + WS_TAB); float* SINH = COSH + 2048 * 64; float* COSR = SINH + 2048 * 64; float* SINR = COSR + 2048 * 32;
    int tid_l = threadIdx.x; asm volatile("" : "+v"(tid_l));
    const int tid = tid_l, lane = tid & 63, wave = __builtin_amdgcn_readfirstlane(tid >> 6), gw = bid * NWAVES + wave;
    constexpr int ph = PH;
    if constexpr (ph == 0) {
        convert_items(args.in, ws, 0, O_D1, gw, NGW, lane); convert_items(args.in, ws, O_OUT, CUTB, gw, NGW, lane);
        for (int idx = bid * NTHR + tid; idx < 2048 * 96; idx += G * NTHR) {
            int pos, j, dim; float* ct; float* st;
            if (idx < 2048 * 64) { pos = idx >> 6; j = idx & 63; dim = 128; ct = COSH + idx; st = SINH + idx; }
            else { const int i2 = idx - 2048 * 64; pos = i2 >> 5; j = i2 & 31; dim = 64; ct = COSR + i2; st = SINR + i2; }
            const float e = -(float)(2 * j) / (float)dim;
            const float invf = (float)exp((double)e * 9.21034037197618273607);
            const float ang = (float)pos * invf;
            float s, c; sincos_d((double)ang, s, c);
            *ct = c; *st = s;
        }
        for (int idx = MROWS + bid * NTHR + tid; idx < ST_TOTAL; idx += G * NTHR) STAT[idx] = 0.f;
        for (int m = gw; m < MROWS; m += NGW) {
            const f32x4* xr = (const f32x4*)(args.in[0] + (size_t)m * DM) + lane;
            u32x2* o = (u32x2*)(XB + (size_t)m * DM) + lane;
            float s = 0.f;
#pragma unroll
            for (int j = 0; j < 8; ++j) { const f32x4 v = __builtin_nontemporal_load(xr + 64 * j); s += (v.x * v.x + v.y * v.y) + (v.z * v.z + v.w * v.w); u32x2 w; w.x = pk2(v.x, v.y); w.y = pk2(v.z, v.w); o[64 * j] = w; }
            s = wave_sum(s);
            if (lane == 0) STAT[ST_SS + m] = s;
        }
    } else if constexpr (ph == NPHASE - 1) {
        const float* g = args.in[17]; const float* ssf = STAT + ST_SS + 6 * MROWS;
        f32x4 gv[8];
#pragma unroll
        for (int j = 0; j < 8; ++j) gv[j] = *(const f32x4*)(g + 4 * lane + 256 * j);
        for (int m = gw; m < MROWS; m += NGW) {
            const f32x4* xr = (const f32x4*)(X + (size_t)m * DM) + lane; f32x4* o = (f32x4*)(args.out + (size_t)m * DM) + lane;
            const float rstd = 1.0f / sqrtf(ssf[m] * (1.0f / DM) + EPS);
#pragma unroll
            for (int j = 0; j < 8; ++j) o[64 * j] = (xr[64 * j] * rstd) * gv[j];
        }
    } else {
        constexpr int l = (ph - 1) / 8, k = (ph - 1) % 8;
        unsigned char* wl = ws + WS_W + (size_t)l * W_LAYER;
        float* SS = STAT + ST_SS + (size_t)(3 * l) * MROWS;
        if constexpr (k == 0 || k == 6) {
            pg8::Gemm g{XB, (const bf16*)(wl + (k == 0 ? WO_GU1 : WO_GU2)), MROWS, 2 * DFF, DM, DM}; pg8::StaticOrder S; S.init(MROWS, 2 * DFF, G, bid);
            pg8::EpiSwiglu E{HP, DFF, SS + (k == 0 ? 0 : 2) * MROWS, 1.0f / DM};
            pg8::gemm_phase<pg8::EpiSwiglu, pg8::StaticOrder, true, true>(lds, g, S, E);
            { constexpr int nwg = (MROWS / 256) * (2 * DFF / 256); const int rem = nwg % G;
              constexpr int lo_ = (l == 0 && k == 0) ? CUTB : (l == 0 && k == 6) ? CUT2 : (l == 1 && k == 0) ? CUT3 : CUT5;
              constexpr int hi_ = (l == 0 && k == 0) ? CUT1 : (l == 0 && k == 6) ? CUT3 : (l == 1 && k == 0) ? CUT4 : CUTE;
              if (rem > 0 && bid >= rem) { if constexpr (l == 0 && k == 0) convert_items(args.in, ws, O_D1, O_OUT, (bid - rem) * NWAVES + wave, (G - rem) * NWAVES, lane);
                  convert_items(args.in, ws, lo_, hi_, (bid - rem) * NWAVES + wave, (G - rem) * NWAVES, lane); } }
        } else if constexpr (k == 1 || k == 5 || k == 7) {
            const bf16* A = (k == 5) ? CAT : HP; const int K = (k == 5) ? DM : DFF;
            const bf16* Bt = (const bf16*)(wl + (k == 1 ? WO_D1 : k == 5 ? WO_OUT : WO_D2));
            pg8::Gemm g{A, Bt, MROWS, DM, K, K}; pg8::StaticOrder S; S.init(MROWS, DM, G, bid);
            pg8::EpiResid E{(l == 0 && k == 1) ? args.in[0] : X, X, XB, SS + (k == 1 ? 1 : k == 5 ? 2 : 3) * MROWS, DM, (k == 5) ? 1.0f : 0.5f, (k == 5) ? 1.0f : 2.0f};
            pg8::gemm_phase<pg8::EpiResid, pg8::StaticOrder, true, true>(lds, g, S, E);
        } else if constexpr (k == 2) {
            pg8::Gemm g{XB, (const bf16*)(wl + WO_IN), MROWS, NPROJ, DM, DM}; pg8::StaticOrder S; S.init(MROWS, NPROJ, G, bid);
            pg8::EpiProj<true> E{HP, NPROJ, 0, 12, 21, COSH, SINH, COSR, SINR, SS + 1 * MROWS, 1.0f / DM, STAT + ST_SSQ + l * MROWS, STAT + ST_SSKV + l * MROWS, STAT + ST_KSUM + l * 16384};
            pg8::gemm_phase<pg8::EpiProj<true>, pg8::StaticOrder, true, true>(lds, g, S, E);
            { constexpr int nwg = (MROWS / 256) * (NPROJ / 256); const int rem = nwg % G;
              constexpr int lo_ = (l == 0 ? CUT1 : CUT4), hi_ = (l == 0 ? CUT2 : CUT5);
              if (rem > 0 && bid >= rem) convert_items(args.in, ws, lo_, hi_, (bid - rem) * NWAVES + wave, (G - rem) * NWAVES, lane); }
        } else if constexpr (k == 3) {
            for (int gi = 0; gi < 2; ++gi) {
                const int N = gi ? 1024 : 768, K = gi ? 256 : 512;
                pg8::Gemm g{HP + (gi ? P_CKV : P_CQ), (const bf16*)(wl + (gi ? WO_UKV : WO_UQ)), MROWS, N, K, NPROJ};
                pg8::StaticOrder S; S.init(MROWS, N, G, gi ? (bid + G - (96 % G)) % G : bid);
                pg8::EpiProj<false> E{gi ? KV : QM, N, 0, 0, gi ? -1 : 2, COSH, SINH, COSR, SINR, STAT + (gi ? ST_SSKV : ST_SSQ) + l * MROWS, gi ? 1.0f / 256.0f : 1.0f / 512.0f, nullptr, nullptr, nullptr};
                pg8::gemm_phase<pg8::EpiProj<false>, pg8::StaticOrder, true, true>(lds, g, S, E);
            }
        } else if constexpr (k == 4) {
            const float L2E = 1.4426950408889634f;
            const float sc_mla = 0.07216878364870322f * L2E, sc_h = 0.08838834764831845f * L2E;
            const float* KSUM = STAT + ST_KSUM + l * 16384;
            unsigned* wq = (unsigned*)(STAT + ST_WQ + 64 * l);
            LAS unsigned* wslot = (LAS unsigned*)(lds + 131072 + 1024);
            for (;;) {
                __syncthreads();
                if (tid == 0) wslot[0] = __hip_atomic_fetch_add(wq, 1u, __ATOMIC_RELAXED, __HIP_MEMORY_SCOPE_AGENT);
                __syncthreads();
                const unsigned u = wslot[0];
                if (u >= 512u) break;
                const int qb = 7 - (int)(u >> 6), idx = (int)(u & 63);
                if (idx < 16) { const int b = idx >> 2, hd = idx & 3;
                    attn_unit<192, 0>(lds, qb, b, QM + hd * 128, 768, QM + 512 + hd * 64, 768, KV + hd * 128, 1024, HP + P_KR, NPROJ, KV + 512 + hd * 128, 1024, CAT + hd * 128, DM, sc_mla, nullptr);
                } else if (idx < 48) { const int j = idx - 16, b = j >> 3, hd = j & 7;
                    attn_unit<128, 2>(lds, qb, b, HP + PQ_DIL + hd * 128, NPROJ, nullptr, 0, HP + PK_DIL + hd * 128, NPROJ, nullptr, 0, HP + PV_DIL + hd * 128, NPROJ, CAT + 1024 + hd * 128, DM, sc_h, nullptr);
                } else { const int j = idx - 48, b = j >> 2, hd = j & 3;
                    attn_unit<128, 1>(lds, qb, b, HP + PQ_MOBA + hd * 128, NPROJ, nullptr, 0, HP + PK_MOBA + hd * 128, NPROJ, nullptr, 0, HP + PV_MOBA + hd * 128, NPROJ, CAT + 512 + hd * 128, DM, sc_h, KSUM + (size_t)j * 1024);
                }
            }
            __syncthreads();
        }
    }
}
__global__ void __launch_bounds__(NTHR, 2) fwd_kernel(Args args) {
    extern __shared__ __attribute__((aligned(16))) unsigned char lds_raw[];
    LAS unsigned char* lds = (LAS unsigned char*)lds_raw;
    const int lo = args.ph_lo, hi = args.ph_hi;
    volatile LAS unsigned* misc = (volatile LAS unsigned*)(lds + 131072 + 512);
    if (threadIdx.x < 2) misc[threadIdx.x] = 0u;
    __syncthreads();
    XcdBarrier bar = xcd_barrier_post((unsigned*)(args.ws + WS_BAR), misc);
#define PHASE(k) if (lo <= (k) && (k) < hi) { run_phase<k>(args, lds); if ((k) + 1 < hi) { if (lo < 0) cg::this_grid().sync(); else xcd_barrier(bar); } }
    PHASE(0) PHASE(1) PHASE(2) PHASE(3) PHASE(4) PHASE(5) PHASE(6) PHASE(7) PHASE(8) PHASE(9) PHASE(10) PHASE(11) PHASE(12) PHASE(13) PHASE(14) PHASE(15) PHASE(16) PHASE(17)
#undef PHASE
    static_assert(NPHASE == 18, "phase list");
}

extern "C" void kernel_launch(void* const* d_in, const int* in_sizes, int n_in, void* d_out, int out_size, void* d_ws, size_t ws_size, hipStream_t stream) {
    static int grid = 0;
    if (grid == 0) {
        if (n_in != 18 || in_sizes[0] != MROWS * DM || out_size != MROWS * DM || ws_size < WS_END) {
            fprintf(stderr, "kernel_launch: unexpected shapes (n_in %d, in0 %d, out %d, ws %zu < %zu)\n", n_in, n_in > 0 ? in_sizes[0] : -1, out_size, ws_size, (size_t)WS_END); grid = -1; return; }
        int dev = 0, cus = 0, per_cu = 0;
        (void)hipGetDevice(&dev); (void)hipDeviceGetAttribute(&cus, hipDeviceAttributeMultiprocessorCount, dev);
        if (hipFuncSetAttribute((const void*)fwd_kernel, hipFuncAttributeMaxDynamicSharedMemorySize, LDS_BYTES) != hipSuccess) { fprintf(stderr, "kernel_launch: hipFuncSetAttribute failed\n"); grid = -1; return; }
        if (hipOccupancyMaxActiveBlocksPerMultiprocessor(&per_cu, (const void*)fwd_kernel, NTHR, LDS_BYTES) != hipSuccess || per_cu < 1) { fprintf(stderr, "kernel_launch: occupancy query says %d\n", per_cu); per_cu = 1; }
        (void)hipGetLastError();
        grid = cus * per_cu;
        if (grid <= 0) grid = 256;
    }
    if (grid < 0) return;
    Args a{};
    for (int i = 0; i < 18; ++i) a.in[i] = (const float*)d_in[i];
    a.out = (float*)d_out; a.ws = (unsigned char*)d_ws;
#if MK_COOP
    a.ph_lo = 0; a.ph_hi = NPHASE;
    (void)hipMemsetAsync((unsigned char*)d_ws + WS_BAR, 0, BAR_BYTES, stream);
    void* kargs[] = {&a};
    hipError_t e = hipLaunchCooperativeKernel((const void*)fwd_kernel, dim3(grid), dim3(NTHR), kargs, LDS_BYTES, stream);
    if (e != hipSuccess) fprintf(stderr, "kernel_launch: cooperative launch failed: %s (grid %d)\n", hipGetErrorString(e), grid);
#else
    for (int ph = 0; ph < NPHASE; ++ph) { a.ph_lo = ph; a.ph_hi = ph + 1; hipLaunchKernelGGL(fwd_kernel, dim3(grid), dim3(NTHR), LDS_BYTES, stream, a); }
#endif
}
```

```cpp
#define MK_COOP 1
#include <hip/hip_runtime.h>
namespace pg8 {
#define PG8_LAS __attribute__((address_space(3)))
typedef unsigned short bf16_t;
typedef short bf16x8 __attribute__((ext_vector_type(8)));
typedef float f32x4 __attribute__((ext_vector_type(4)));
typedef unsigned u32x4 __attribute__((ext_vector_type(4)));
constexpr int BM = 256, BK = 64, HALF = 128, HTB = HALF * BK * 2  , STAGE_BYTES = 8 * HTB, NXCD = 8, WGM = 8;

__host__ __device__ __forceinline__ int lds_byte(int r, int c) { const int st = (r >> 4) * 2 + (c >> 5), rr = r & 15, cc = c & 31, ob = rr * 64 + cc * 2; return st * 1024 + (ob ^ (((ob >> 9) & 1) << 5)); }
__host__ __device__ __forceinline__ void stage_rc(int b, int& R, int& C) { const int st = b / 1024, sb = b % 1024, swz = sb ^ (((sb >> 9) & 1) << 5); R = (st >> 1) * 16 + swz / 64; C = (st & 1) * 32 + (swz % 64) / 2; }
__host__ __device__ __forceinline__ int perm32(int rho) { const int n = rho >> 4, i = rho & 15; return 8 * (i >> 2) + 4 * n + (i & 3); }

struct Unit { int pm, pn; };
struct Gemm { const bf16_t* A; const bf16_t* Bt; int M, N, K, lda; };

struct StaticOrder {
    int nM, nN, nwg, G, c;
    __host__ __device__ void init(int M, int N, int G_, int c_) { nM = M / BM; nN = N / BM; nwg = nM * nN; G = G_; c = c_; }
    __host__ __device__ bool next(int i, Unit& u) const {
        const long L = (long)i * G + c; if (L >= nwg) return false;
        int wgid = (int)L; { const int q = nwg / NXCD, r = nwg % NXCD, xcd = wgid % NXCD, off = wgid / NXCD; wgid = (xcd < r ? xcd * (q + 1) : r * (q + 1) + (xcd - r) * q) + off; }
        const int nig = WGM * nN, gid = wgid / nig, fm = gid * WGM, gsz = (nM - fm) < WGM ? (nM - fm) : WGM;
        u.pm = fm + ((wgid % nig) % gsz); u.pn = (wgid % nig) / gsz; return true;
    }
    __device__ __forceinline__ void a_ready(const Unit&) const {}
    __device__ __forceinline__ void done(const Unit&) const {}
};
__device__ __forceinline__ unsigned cvt_pk_bf16(float lo, float hi) { unsigned r; asm volatile("v_cvt_pk_bf16_f32 %0, %1, %2" : "=v"(r) : "v"(lo), "v"(hi)); return r; }
typedef float f32x2 __attribute__((ext_vector_type(2)));
typedef unsigned u32x2 __attribute__((ext_vector_type(2)));
__device__ __forceinline__ float silu_f(float g) { return g * __builtin_amdgcn_rcpf(1.0f + __builtin_amdgcn_exp2f(-1.4426950408889634f * g)); }
__device__ __forceinline__ void atomic_addf(float* p, float v) { (void)__hip_atomic_fetch_add(p, v, __ATOMIC_RELAXED, __HIP_MEMORY_SCOPE_AGENT); }
__device__ __forceinline__ float row_rstd(const float* ss, int row, float invd) { return 1.0f / sqrtf(ss[row] * invd + 1e-6f); }
struct EpiSwiglu {
    static constexpr bool PERM = true, AFTER_DRAIN = false, INIT = false, PRE = true;
    bf16_t* H; int ldh; const float* ss; float invd;
    __device__ __forceinline__ void pre(float (&p)[8], const Unit& u, int wr, int fr) const {
#pragma unroll
        for (int i = 0; i < 8; ++i) p[i] = ss[u.pm * BM + wr * 64 + fr + (i >> 2) * HALF + (i & 3) * 16];
    }
    __device__ __forceinline__ void operator()(const f32x4 (&acc)[2][2][4][2], const Unit& u, int wr, int wc, int fr, int fq, const float (&p)[8]) const {
        const int row0 = u.pm * BM + wr * 64 + fr, col0 = u.pn * HALF + wc * 32 + 8 * fq;
#pragma unroll
        for (int ai = 0; ai < 2; ++ai)
#pragma unroll
            for (int m = 0; m < 4; ++m) {
                const int row = row0 + ai * HALF + m * 16;
                const float rs = 1.0f / sqrtf(p[ai * 4 + m] * invd + 1e-6f);
                bf16_t* rowp = H + (size_t)row * ldh + col0;
                const f32x4 g0 = acc[ai][0][m][0] * rs, g1 = acc[ai][0][m][1] * rs, u0 = acc[ai][1][m][0] * rs, u1 = acc[ai][1][m][1] * rs;
                u32x4 w;
                w.x = cvt_pk_bf16(silu_f(g0[0]) * u0[0], silu_f(g0[1]) * u0[1]); w.y = cvt_pk_bf16(silu_f(g0[2]) * u0[2], silu_f(g0[3]) * u0[3]);
                w.z = cvt_pk_bf16(silu_f(g1[0]) * u1[0], silu_f(g1[1]) * u1[1]); w.w = cvt_pk_bf16(silu_f(g1[2]) * u1[2], silu_f(g1[3]) * u1[3]);
                *(u32x4*)rowp = w;
            }
    }
};
struct EpiResid {
    static constexpr bool PERM = true, AFTER_DRAIN = false, INIT = true, PRE = false;
    const float* src; float* dst; bf16_t* xb; float* ss; int ld; float scale, rscale;
    __device__ __forceinline__ void init(f32x4 (&acc)[2][2][4][2], const Unit& u, int wr, int wc, int fr, int fq) const {
        const int row0 = u.pm * BM + wr * 64 + fr, col0 = u.pn * BM + wc * 32 + 8 * fq;
#pragma unroll
        for (int ai = 0; ai < 2; ++ai)
#pragma unroll
            for (int m = 0; m < 4; ++m) {
                const size_t off = (size_t)(row0 + ai * HALF + m * 16) * ld + col0;
#pragma unroll
                for (int bj = 0; bj < 2; ++bj) { acc[ai][bj][m][0] = *(const f32x4*)(src + off + bj * HALF) * rscale; acc[ai][bj][m][1] = *(const f32x4*)(src + off + bj * HALF + 4) * rscale; }
            }
    }
    __device__ __forceinline__ void operator()(const f32x4 (&acc)[2][2][4][2], const Unit& u, int wr, int wc, int fr, int fq) const {
        const int row0 = u.pm * BM + wr * 64 + fr, col0 = u.pn * BM + wc * 32 + 8 * fq;
#pragma unroll
        for (int ai = 0; ai < 2; ++ai)
#pragma unroll
            for (int m = 0; m < 4; ++m) {
                const int row = row0 + ai * HALF + m * 16;
                const size_t off = (size_t)row * ld + col0;
                float sq = 0.f;
#pragma unroll
                for (int bj = 0; bj < 2; ++bj) {
                    const size_t o = off + bj * HALF;
                    const f32x4 y0 = acc[ai][bj][m][0] * scale, y1 = acc[ai][bj][m][1] * scale;
                    *(f32x4*)(dst + o) = y0; *(f32x4*)(dst + o + 4) = y1;
                    sq += (y0[0] * y0[0] + y0[1] * y0[1]) + (y0[2] * y0[2] + y0[3] * y0[3]) + (y1[0] * y1[0] + y1[1] * y1[1]) + (y1[2] * y1[2] + y1[3] * y1[3]);
                    u32x4 w; w.x = cvt_pk_bf16(y0[0], y0[1]); w.y = cvt_pk_bf16(y0[2], y0[3]); w.z = cvt_pk_bf16(y1[0], y1[1]); w.w = cvt_pk_bf16(y1[2], y1[3]);
                    *(u32x4*)(xb + o) = w;
                }
                sq += __shfl_xor(sq, 16); sq += __shfl_xor(sq, 32);
                if (fq == 0) atomic_addf(ss + row, sq);
            }
    }
};
template <bool WIN> struct EpiProj {
    static constexpr bool PERM = true, AFTER_DRAIN = false, INIT = false, PRE = false;
    bf16_t* O; int ldc; int r64lo, r64hi, r32t; const float* cos64; const float* sin64; const float* cos32; const float* sin32;
    const float* ss; float invd; float* ssq; float* sskv; float* ksum;
    __device__ __forceinline__ void operator()(const f32x4 (&acc)[2][2][4][2], const Unit& u, int wr, int wc, int fr, int fq) const {
        const int row0 = u.pm * BM + wr * 64 + fr;
        const bool rope64 = (u.pn >= r64lo && u.pn < r64hi), rope32 = (u.pn == r32t);
        if (rope64 || rope32) {
            const int RH = rope64 ? 64 : 32;
            const int hh = rope64 ? (wc >> 1) : wc;
            const int j0 = rope64 ? (32 * (wc & 1) + 8 * fq) : 8 * fq;
            const int colb = u.pn * BM + 2 * RH * hh + j0;
            const float* cT = rope64 ? cos64 : cos32; const float* sT = rope64 ? sin64 : sin32;
            f32x4 k0 = {0.f, 0.f, 0.f, 0.f}, k1 = k0, k2 = k0, k3 = k0;
#pragma unroll
            for (int ai = 0; ai < 2; ++ai)
#pragma unroll
                for (int m = 0; m < 4; ++m) {
                    const int row = row0 + ai * HALF + m * 16, pos = row & 2047;
                    const float rs = row_rstd(ss, row, invd);
                    const f32x4 c0 = *(const f32x4*)(cT + pos * RH + j0), c1 = *(const f32x4*)(cT + pos * RH + j0 + 4);
                    const f32x4 s0 = *(const f32x4*)(sT + pos * RH + j0), s1 = *(const f32x4*)(sT + pos * RH + j0 + 4);
                    const f32x4 xa = acc[ai][0][m][0] * rs, xb = acc[ai][0][m][1] * rs, ya = acc[ai][1][m][0] * rs, yb = acc[ai][1][m][1] * rs;
                    const f32x4 pa = xa * c0 - ya * s0, pb = xb * c1 - yb * s1, qa = ya * c0 + xa * s0, qb = yb * c1 + xb * s1;
                    bf16_t* rowp = O + (size_t)row * ldc + colb;
                    u32x4 w; w.x = cvt_pk_bf16(pa[0], pa[1]); w.y = cvt_pk_bf16(pa[2], pa[3]); w.z = cvt_pk_bf16(pb[0], pb[1]); w.w = cvt_pk_bf16(pb[2], pb[3]);
                    *(u32x4*)rowp = w;
                    u32x4 v; v.x = cvt_pk_bf16(qa[0], qa[1]); v.y = cvt_pk_bf16(qa[2], qa[3]); v.z = cvt_pk_bf16(qb[0], qb[1]); v.w = cvt_pk_bf16(qb[2], qb[3]);
                    *(u32x4*)(rowp + RH) = v;
                    if (WIN) { k0 += pa; k1 += pb; k2 += qa; k3 += qb; }
                }
            if (WIN && (u.pn == 2 || u.pn == 3)) {
#pragma unroll
                for (int e = 0; e < 4; ++e)
#pragma unroll
                    for (int o = 1; o < 16; o <<= 1) { k0[e] += __shfl_xor(k0[e], o); k1[e] += __shfl_xor(k1[e], o); k2[e] += __shfl_xor(k2[e], o); k3[e] += __shfl_xor(k3[e], o); }
                if (fr == 0) {
                    float* kp = ksum + ((size_t)(((u.pm >> 3) * 4 + 2 * (u.pn - 2) + hh) * 8 + (u.pm & 7))) * 128 + j0;
#pragma unroll
                    for (int e = 0; e < 4; ++e) { atomic_addf(kp + e, k0[e]); atomic_addf(kp + 4 + e, k1[e]); atomic_addf(kp + 64 + e, k2[e]); atomic_addf(kp + 68 + e, k3[e]); }
                }
            }
        } else {
            const int col0 = u.pn * BM + wc * 32 + 8 * fq;
            float* sqdst = nullptr;
            if (WIN) sqdst = (u.pn == 18 || u.pn == 19) ? ssq : (u.pn == 20) ? sskv : nullptr;
#pragma unroll
            for (int ai = 0; ai < 2; ++ai)
#pragma unroll
                for (int m = 0; m < 4; ++m) {
                    const int row = row0 + ai * HALF + m * 16;
                    const float rs = row_rstd(ss, row, invd);
                    bf16_t* rowp = O + (size_t)row * ldc + col0;
                    float sq = 0.f;
#pragma unroll
                    for (int bj = 0; bj < 2; ++bj) { const f32x4 v0 = acc[ai][bj][m][0] * rs, v1 = acc[ai][bj][m][1] * rs;
                        if (WIN) sq += (v0[0] * v0[0] + v0[1] * v0[1]) + (v0[2] * v0[2] + v0[3] * v0[3]) + (v1[0] * v1[0] + v1[1] * v1[1]) + (v1[2] * v1[2] + v1[3] * v1[3]);
                        u32x4 w; w.x = cvt_pk_bf16(v0[0], v0[1]); w.y = cvt_pk_bf16(v0[2], v0[3]); w.z = cvt_pk_bf16(v1[0], v1[1]); w.w = cvt_pk_bf16(v1[2], v1[3]);
                        *(u32x4*)(rowp + bj * HALF) = w; }
                    if (WIN && sqdst) { sq += __shfl_xor(sq, 16); sq += __shfl_xor(sq, 32); if (fq == 0) atomic_addf(sqdst + row, sq); }
                }
        }
    }
};
template <class Epi, class Sched, bool ALIGN_EPI = false, bool SP2 = false>
__device__ __forceinline__ void gemm_phase(PG8_LAS unsigned char* lds, const Gemm g, const Sched& S, const Epi& E) {
    int tid_l = threadIdx.x; asm volatile("" : "+v"(tid_l)); const int tid = tid_l, wid = __builtin_amdgcn_readfirstlane(tid >> 6), lane = tid & 63, wr = wid >> 2, wc = wid & 3, fr = lane & 15, fq = lane >> 4;
    const int K = g.K, nt = K / BK;
    unsigned voffA[2], voffB[2];
#pragma unroll
    for (int i = 0; i < 2; ++i) { int R, C; stage_rc(tid * 16 + i * 8192, R, C); const int Rb = Epi::PERM ? ((R & ~31) + perm32(R & 31)) : R;
        voffA[i] = (unsigned)(R * g.lda + C) * 2u; voffB[i] = (unsigned)(Rb * K + C) * 2u; }
    const size_t kstep = (size_t)(BK * 2);
    const size_t hstep = (size_t)HALF * K * 2, hstepA = (size_t)HALF * g.lda * 2;
    const size_t tstep = 2 * hstep, tstepA = 2 * hstepA;
    const unsigned ldsw = (unsigned)wid * 1024u;
    const int aoff = lds_byte(wr * 64 + fr, fq * 8), boff = lds_byte(wc * 32 + fr, fq * 8);
#define PG8_SA(b, h) (((b) * 2 + (h)) * HTB)
#define PG8_SB(b, h) ((4 + (b) * 2 + (h)) * HTB)
#define PG8_STAGE(bufoff, gbase, voff) do { _Pragma("unroll") for (int _i = 0; _i < 2; ++_i) \
        __builtin_amdgcn_global_load_lds((const unsigned*)((const char*)(gbase) + (voff)[_i]), (PG8_LAS unsigned*)(lds + (bufoff) + ldsw + _i * 8192), 16, 0, 0); } while (0)
#define PG8_LDA(dst, b, h) do { _Pragma("unroll") for (int m = 0; m < 4; ++m) _Pragma("unroll") for (int k = 0; k < 2; ++k) dst[m][k] = *(const PG8_LAS bf16x8*)(lds + PG8_SA(b, h) + aoff + m * 2048 + k * 1024); } while (0)
#define PG8_LDB(dst, b, h) do { _Pragma("unroll") for (int n = 0; n < 2; ++n) _Pragma("unroll") for (int k = 0; k < 2; ++k) dst[n][k] = *(const PG8_LAS bf16x8*)(lds + PG8_SB(b, h) + boff + n * 2048 + k * 1024); } while (0)
#define PG8_MMA(ai, bj, At, Bt) do { __builtin_amdgcn_s_setprio(1); _Pragma("unroll") for (int m = 0; m < 4; ++m) _Pragma("unroll") for (int n = 0; n < 2; ++n) _Pragma("unroll") for (int k = 0; k < 2; ++k) \
        acc[ai][bj][m][n] = __builtin_amdgcn_mfma_f32_16x16x32_bf16(Bt[n][k], At[m][k], acc[ai][bj][m][n], 0, 0, 0); __builtin_amdgcn_s_setprio(0); } while (0)
#define PG8_WAIT_V(n) asm volatile("s_waitcnt vmcnt(" #n ")" ::: "memory")
#define PG8_WAIT_L(n) asm volatile("s_waitcnt lgkmcnt(" #n ")" ::: "memory")
#define PG8_BAR __builtin_amdgcn_s_barrier()
#define PG8_SCHED __builtin_amdgcn_sched_barrier(0)
    Unit cur, nxt; int ui = 0;
    if (!S.next(0, cur)) return;
    f32x4 acc[2][2][4][2];
    if constexpr (Epi::INIT) E.init(acc, cur, wr, wc, fr, fq);
    else {
#pragma unroll
    for (int a = 0; a < 2; ++a)
#pragma unroll
        for (int b = 0; b < 2; ++b)
#pragma unroll
            for (int m = 0; m < 4; ++m)
#pragma unroll
                for (int n = 0; n < 2; ++n) acc[a][b][m][n] = (f32x4){0.f, 0.f, 0.f, 0.f};
    }
    float pre[8];
    if constexpr (Epi::PRE) E.pre(pre, cur, wr, fr);
    bf16x8 At[4][2], B0[2][2], B1[2][2];
    const char* cA = (const char*)g.A + (size_t)cur.pm * tstepA; const char* cB = (const char*)g.Bt + (size_t)cur.pn * tstep;
    S.a_ready(cur);
    if constexpr (SP2) {
        PG8_STAGE(PG8_SB(0, 0), cB, voffB); PG8_STAGE(PG8_SB(0, 1), cB + hstep, voffB); PG8_STAGE(PG8_SA(0, 0), cA, voffA); PG8_STAGE(PG8_SA(0, 1), cA + hstepA, voffA);
        if (wr == 1) PG8_BAR;
        PG8_WAIT_V(2); PG8_BAR;
        PG8_STAGE(PG8_SB(1, 0), cB + kstep, voffB); PG8_STAGE(PG8_SA(1, 0), cA + kstep, voffA); PG8_STAGE(PG8_SB(1, 1), cB + hstep + kstep, voffB);
        PG8_WAIT_V(6); PG8_BAR;
    } else {
        PG8_STAGE(PG8_SB(0, 0), cB, voffB); PG8_STAGE(PG8_SA(0, 0), cA, voffA); PG8_STAGE(PG8_SB(0, 1), cB + hstep, voffB); PG8_STAGE(PG8_SA(0, 1), cA + hstepA, voffA);
        if (wr == 1) PG8_BAR;
        PG8_WAIT_V(4); PG8_BAR;
        PG8_STAGE(PG8_SB(1, 0), cB + kstep, voffB); PG8_STAGE(PG8_SA(1, 0), cA + kstep, voffA); PG8_STAGE(PG8_SB(1, 1), cB + hstep + kstep, voffB);
        PG8_WAIT_V(6); PG8_BAR;
    }
    for (;;) {
        const bool has_next = S.next(ui + 1, nxt);
        const char* nA = has_next ? (const char*)g.A + (size_t)nxt.pm * tstepA : cA; const char* nB = has_next ? (const char*)g.Bt + (size_t)nxt.pn * tstep : cB;
        for (int t = 0; t < nt; t += 2) {
            const bool last = (t == nt - 2);
            const char* a1 = cA + (size_t)(t + 1) * kstep;
            const char* a2 = last ? nA : cA + (size_t)(t + 2) * kstep; const char* b2 = last ? nB : cB + (size_t)(t + 2) * kstep;
            const char* a3 = a2 + kstep; const char* b3 = b2 + kstep;
            if (last && has_next) S.a_ready(nxt);
            if constexpr (SP2) {
            PG8_LDB(B0, 0, 0); PG8_LDB(B1, 0, 1); PG8_SCHED; PG8_LDA(At, 0, 0); PG8_STAGE(PG8_SA(1, 1), a1 + hstepA, voffA);
            PG8_WAIT_V(8); PG8_WAIT_L(0); PG8_BAR; PG8_MMA(0, 0, At, B0); PG8_MMA(0, 1, At, B1); PG8_BAR; PG8_SCHED;
            PG8_LDA(At, 0, 1); PG8_STAGE(PG8_SB(0, 0), b2, voffB); PG8_STAGE(PG8_SB(0, 1), b2 + hstep, voffB); PG8_STAGE(PG8_SA(0, 0), a2, voffA);
            PG8_WAIT_V(8); PG8_WAIT_L(0); PG8_BAR; PG8_MMA(1, 0, At, B0); PG8_MMA(1, 1, At, B1); PG8_BAR; PG8_SCHED;
            PG8_LDB(B0, 1, 0); PG8_LDB(B1, 1, 1); PG8_SCHED; PG8_LDA(At, 1, 0); PG8_STAGE(PG8_SA(0, 1), a2 + hstepA, voffA);
            PG8_WAIT_V(8); PG8_WAIT_L(0); PG8_BAR; PG8_MMA(0, 0, At, B0); PG8_MMA(0, 1, At, B1); PG8_BAR; PG8_SCHED;
            PG8_LDA(At, 1, 1); PG8_STAGE(PG8_SB(1, 0), b3, voffB); PG8_STAGE(PG8_SB(1, 1), b3 + hstep, voffB); PG8_STAGE(PG8_SA(1, 0), a3, voffA);
            PG8_WAIT_V(8); PG8_WAIT_L(0); PG8_BAR; PG8_MMA(1, 0, At, B0); PG8_MMA(1, 1, At, B1); PG8_BAR; PG8_SCHED;
            } else {
            PG8_LDB(B0, 0, 0); PG8_SCHED; PG8_LDA(At, 0, 0); PG8_STAGE(PG8_SA(1, 1), a1 + hstepA, voffA);
            PG8_WAIT_L(8); PG8_BAR; PG8_WAIT_L(0); PG8_MMA(0, 0, At, B0); PG8_BAR; PG8_SCHED;
            PG8_LDB(B1, 0, 1); PG8_STAGE(PG8_SB(0, 0), b2, voffB);
            PG8_BAR; PG8_WAIT_L(0); PG8_MMA(0, 1, At, B1); PG8_BAR;
            PG8_LDA(At, 0, 1); PG8_STAGE(PG8_SA(0, 0), a2, voffA);
            PG8_BAR; PG8_WAIT_L(0); PG8_MMA(1, 0, At, B0); PG8_BAR; PG8_SCHED;
            PG8_STAGE(PG8_SB(0, 1), b2 + hstep, voffB);
            PG8_WAIT_V(6); PG8_BAR; PG8_MMA(1, 1, At, B1); PG8_BAR;
            PG8_LDB(B0, 1, 0); PG8_SCHED; PG8_LDA(At, 1, 0); PG8_STAGE(PG8_SA(0, 1), a2 + hstepA, voffA);
            PG8_WAIT_L(8); PG8_BAR; PG8_WAIT_L(0); PG8_MMA(0, 0, At, B0); PG8_BAR; PG8_SCHED;
            PG8_LDB(B1, 1, 1); PG8_STAGE(PG8_SB(1, 0), b3, voffB);
            PG8_BAR; PG8_WAIT_L(0); PG8_MMA(0, 1, At, B1); PG8_BAR;
            PG8_LDA(At, 1, 1); PG8_STAGE(PG8_SA(1, 0), a3, voffA);
            PG8_BAR; PG8_WAIT_L(0); PG8_MMA(1, 0, At, B0); PG8_BAR; PG8_SCHED;
            PG8_STAGE(PG8_SB(1, 1), b3 + hstep, voffB);
            PG8_WAIT_V(6); PG8_BAR; PG8_MMA(1, 1, At, B1); PG8_BAR;
            }
        }
        if constexpr (ALIGN_EPI) { if (wr == 0) PG8_BAR; }
        if constexpr (!Epi::AFTER_DRAIN) { if constexpr (Epi::PRE) E(acc, cur, wr, wc, fr, fq, pre); else E(acc, cur, wr, wc, fr, fq); S.done(cur); }
        if (!has_next) break;
        if constexpr (Epi::PRE) E.pre(pre, nxt, wr, fr);
        if constexpr (Epi::INIT) E.init(acc, nxt, wr, wc, fr, fq);
        else {
#pragma unroll
        for (int a = 0; a < 2; ++a)
#pragma unroll
            for (int b = 0; b < 2; ++b)
#pragma unroll
                for (int m = 0; m < 4; ++m)
#pragma unroll
                    for (int n = 0; n < 2; ++n) acc[a][b][m][n] = (f32x4){0.f, 0.f, 0.f, 0.f};
        }
        cur = nxt; cA = nA; cB = nB; ++ui;
        if constexpr (ALIGN_EPI) { if (wr == 1) PG8_BAR; }
    }
    PG8_WAIT_V(0);
    if constexpr (!ALIGN_EPI) { if (wr == 0) PG8_BAR; }
    PG8_BAR;
    if constexpr (Epi::AFTER_DRAIN) { E.fused(acc, cur, wr, wc, fr, fq, lds, wid, lane); S.done(cur); }
#undef PG8_SA
#undef PG8_SB
#undef PG8_STAGE
#undef PG8_LDA
#undef PG8_LDB
#undef PG8_MMA
#undef PG8_WAIT_V
#undef PG8_WAIT_L
#undef PG8_BAR
#undef PG8_SCHED
}
}

#include <hip/hip_cooperative_groups.h>
#include <cstdio>
#include <cstdint>
namespace cg = cooperative_groups;
#ifndef EN_G1
#define EN_G1 1
#endif
#ifndef EN_G2
#define EN_G2 1
#endif
#ifndef EN_G3
#define EN_G3 1
#endif
#ifndef EN_G4
#define EN_G4 1
#endif
#ifndef EN_A0
#define EN_A0 1
#endif
#ifndef EN_A1
#define EN_A1 1
#endif
#ifndef EN_A2
#define EN_A2 1
#endif
#ifndef MK_COOP
#define MK_COOP 1
#endif
#define LAS __attribute__((address_space(3)))
typedef unsigned short bf16;
typedef short bf16x8 __attribute__((ext_vector_type(8)));
typedef short s16x4 __attribute__((ext_vector_type(4)));
typedef float f32x4 __attribute__((ext_vector_type(4)));
typedef float f32x16 __attribute__((ext_vector_type(16)));
typedef unsigned u32x4 __attribute__((ext_vector_type(4)));
typedef unsigned u32x2 __attribute__((ext_vector_type(2)));

constexpr int NWAVES = 8, NTHR = 512;
constexpr int SEQ = 2048, DM = 2048, MROWS = 8192, DFF = 5632, DEPTH = 2;
constexpr int NPROJ = 5632;
constexpr int IN_W = 5440;
constexpr float EPS = 1e-6f;
constexpr int NPHASE = 2 + 8 * DEPTH;
constexpr int PQ_MOBA = 0, PK_MOBA = 512, PQ_DIL = 1024, PK_DIL = 2048, PV_MOBA = 3072, PV_DIL = 3584, P_CQ = 4608, P_CKV = 5120, P_KR = 5376;

constexpr size_t SZ_GU = (size_t)2 * DFF * DM * 2, SZ_D = (size_t)DM * DFF * 2, SZ_IN = (size_t)NPROJ * DM * 2, SZ_UQ = (size_t)768 * 512 * 2, SZ_UKV = (size_t)1024 * 256 * 2, SZ_OUT = (size_t)DM * DM * 2;
constexpr size_t WO_GU1 = 0, WO_D1 = WO_GU1 + SZ_GU, WO_IN = WO_D1 + SZ_D, WO_UQ = WO_IN + SZ_IN, WO_UKV = WO_UQ + SZ_UQ, WO_OUT = WO_UKV + SZ_UKV, WO_GU2 = WO_OUT + SZ_OUT, WO_D2 = WO_GU2 + SZ_GU, W_LAYER = WO_D2 + SZ_D;
constexpr size_t WS_W = 0;
constexpr size_t WS_X = WS_W + DEPTH * W_LAYER;
constexpr size_t WS_XB = WS_X + (size_t)MROWS * DM * 4;
constexpr size_t WS_HP = WS_XB + (size_t)MROWS * DM * 2;
constexpr size_t WS_CAT = WS_HP + (size_t)MROWS * NPROJ * 2;
constexpr size_t WS_QM = WS_CAT + (size_t)MROWS * DM * 2;
constexpr size_t WS_KV = WS_QM + (size_t)MROWS * 768 * 2;
constexpr size_t WS_STAT = WS_KV + (size_t)MROWS * 1024 * 2;
constexpr int ST_SS = 0, ST_SSQ = 7 * MROWS, ST_SSKV = 9 * MROWS, ST_KSUM = 11 * MROWS, ST_WQ = 11 * MROWS + 2 * 16384  , ST_TOTAL = ST_WQ + 128;
constexpr size_t WS_TAB = WS_STAT + (size_t)ST_TOTAL * 4;
constexpr size_t WS_BAR = WS_TAB + (size_t)2048 * (64 + 64 + 32 + 32) * 4;
constexpr size_t BAR_BYTES = 16384;
constexpr size_t WS_END = WS_BAR + BAR_BYTES;
constexpr int LDS_BYTES = 147456;

__device__ __forceinline__ float wave_sum(float v) {
#pragma unroll
    for (int o = 1; o < 64; o <<= 1) v += __shfl_xor(v, o);
    return v;
}
__device__ __forceinline__ unsigned f2bf(float f) { unsigned u = __builtin_bit_cast(unsigned, f); return (u + 0x7fffu + ((u >> 16) & 1u)) >> 16; }
__device__ __forceinline__ unsigned pk2(float lo, float hi) { return f2bf(lo) | (f2bf(hi) << 16); }
__device__ __forceinline__ float bf2f(short v) { return __uint_as_float(((unsigned)(unsigned short)v) << 16); }
#define LDS_WAIT() asm volatile("s_waitcnt lgkmcnt(0)" ::: "memory")

__device__ __forceinline__ void conv_item(const float* Wc  , int NS, int K, bf16* WT  , const float* gk  , int lane) {
    const int r = lane >> 3, c = lane & 7;
    f32x4 v[16];
    if (Wc) {
#pragma unroll
        for (int i = 0; i < 16; ++i) { const int k = (i < 8) ? 8 * r + i : 64 + 8 * r + (i - 8); v[i] = __builtin_nontemporal_load((const f32x4*)(Wc + (size_t)k * NS + 4 * c)); }
        if (gk) {
#pragma unroll
            for (int hf = 0; hf < 2; ++hf) { const f32x4 g0 = *(const f32x4*)(gk + 64 * hf + 8 * r), g1 = *(const f32x4*)(gk + 64 * hf + 8 * r + 4);
                v[8 * hf + 0] *= g0.x; v[8 * hf + 1] *= g0.y; v[8 * hf + 2] *= g0.z; v[8 * hf + 3] *= g0.w; v[8 * hf + 4] *= g1.x; v[8 * hf + 5] *= g1.y; v[8 * hf + 6] *= g1.z; v[8 * hf + 7] *= g1.w; }
        }
    } else {
#pragma unroll
        for (int i = 0; i < 16; ++i) v[i] = (f32x4){0.f, 0.f, 0.f, 0.f};
    }
#pragma unroll
    for (int e = 0; e < 4; ++e)
#pragma unroll
        for (int hf = 0; hf < 2; ++hf) {
            u32x4 o; o.x = pk2(v[8 * hf + 0][e], v[8 * hf + 1][e]); o.y = pk2(v[8 * hf + 2][e], v[8 * hf + 3][e]); o.z = pk2(v[8 * hf + 4][e], v[8 * hf + 5][e]); o.w = pk2(v[8 * hf + 6][e], v[8 * hf + 7][e]);
            *(u32x4*)(WT + (size_t)(4 * c + e) * K + 64 * hf + 8 * r) = o;
        }
}
__device__ __forceinline__ int win_srccol(int n0) {
    const int t = n0 >> 8, w = n0 & 255, bj = w >> 7, c = w & 127;
    if (t < 12) { const int base = t < 2 ? 832 + 256 * t : t < 4 ? 1344 + 256 * (t - 2) : t < 8 ? 2368 + 256 * (t - 4) : 3392 + 256 * (t - 8); return base + 128 * (c >> 6) + 64 * bj + (c & 63); }
    if (t < 14) return 1856 + 256 * (t - 12) + w;
    if (t < 18) return 4416 + 256 * (t - 14) + w;
    if (t < 20) return 256 * (t - 18) + w;
    if (t == 20) return 512 + w;
    return c < 32 ? 768 + 32 * bj + c : -1;
}
constexpr int IT_GU = (DM / 128) * (2 * DFF / 32), IT_D = (DFF / 128) * (DM / 32), IT_IN = (DM / 128) * (NPROJ / 32), IT_UQ = (512 / 128) * (768 / 32), IT_UKV = (256 / 128) * (1024 / 32), IT_OUT = (DM / 128) * (DM / 32);
constexpr int IT_LAYER = 2 * IT_GU + 2 * IT_D + IT_IN + IT_UQ + IT_UKV + IT_OUT;

__device__ __forceinline__ void sincos_d(double x, float& s, float& c) {
    const double kq = __builtin_rint(x * 0.63661977236758134308);
    const int q = ((int)kq) & 3;
    double r = __builtin_fma(-kq, 1.57079632679489655800e+00, x); r = __builtin_fma(-kq, 6.12323399573676603587e-17, r);
    const double r2 = r * r;
    double sp = -1.0 / 1307674368000.0; sp = sp * r2 + 1.0 / 6227020800.0; sp = sp * r2 - 1.0 / 39916800.0; sp = sp * r2 + 1.0 / 362880.0; sp = sp * r2 - 1.0 / 5040.0; sp = sp * r2 + 1.0 / 120.0; sp = sp * r2 - 1.0 / 6.0;
    const double sn = r + r * r2 * sp;
    double cp = 1.0 / 20922789888000.0; cp = cp * r2 - 1.0 / 87178291200.0; cp = cp * r2 + 1.0 / 479001600.0; cp = cp * r2 - 1.0 / 3628800.0; cp = cp * r2 + 1.0 / 40320.0; cp = cp * r2 - 1.0 / 720.0; cp = cp * r2 + 1.0 / 24.0; cp = cp * r2 - 0.5;
    const double cs = 1.0 + r2 * cp;
    const double so = (q == 0) ? sn : (q == 1) ? cs : (q == 2) ? -sn : -cs;
    const double co = (q == 0) ? cs : (q == 1) ? -sn : (q == 2) ? -cs : sn;
    s = (float)so; c = (float)co;
}

constexpr int ATT_KOFF = 0, ATT_VOFF = 64 * 400, ATT_VP = 320, ATT_BUF = ATT_VOFF + 64 * ATT_VP, ATT_KMOFF = 2 * ATT_BUF;
#define MFMA32(a, b, c) __builtin_amdgcn_mfma_f32_32x32x16_bf16((a), (b), (c), 0, 0, 0)
#define SCHED_FENCE() __builtin_amdgcn_sched_barrier(0)
constexpr float ATT_THR = 8.0f;
typedef short v4i16_t __attribute__((ext_vector_type(4)));
__device__ __forceinline__ s16x4 vtr(const LAS unsigned char* p) { return __builtin_bit_cast(s16x4, __builtin_amdgcn_ds_read_tr16_b64_v4i16((LAS v4i16_t*)p)); }
typedef float f32x2_t __attribute__((ext_vector_type(2))); typedef __bf16 bf16x2_t __attribute__((ext_vector_type(2)));
__device__ __forceinline__ unsigned cvtpk(float lo, float hi) { f32x2_t v = {lo, hi}; bf16x2_t b = __builtin_convertvector(v, bf16x2_t); return __builtin_bit_cast(unsigned, b); }
__device__ __forceinline__ float dil_lw(int d) {
    if (d < 0) return -INFINITY;
    const int w = (d <= 128 ? 1 : 0) + ((((d & 3) == 0) && d <= 512) ? 1 : 0) + (((d & 15) == 0) ? 1 : 0);
    return w == 0 ? -INFINITY : w == 1 ? 0.f : w == 2 ? 1.f : 1.5849625007211562f;
}
__device__ __forceinline__ float max3(float a, float b, float c) { return fmaxf(fmaxf(a, b), c); }

template <int DQK, int MODE>
__device__ __forceinline__ void attn_unit(LAS unsigned char* lds, int qb, int b,
        const bf16* Q1, int ldq1, const bf16* Q2, int ldq2, const bf16* K1, int ldk1, const bf16* K2, int ldk2,
        const bf16* V, int ldv, bf16* O, int ldo, float sc, const float* kmean) {
    constexpr int NKS = DQK / 16, KP = DQK * 2 + 16, KB = 2, NBT = NKS / KB;
    int tid_l = threadIdx.x; asm volatile("" : "+v"(tid_l));
    const int tid = tid_l, lane = tid & 63, wid = __builtin_amdgcn_readfirstlane(tid >> 6), r32 = lane & 31, h = lane >> 5;
    const int q0w = qb * 256 + wid * 32, qp = q0w + r32;
    const size_t rowb = (size_t)b * SEQ;
    bf16x8 qf[NKS];
#pragma unroll
    for (int ks = 0; ks < NKS; ++ks) { const int d = 16 * ks + 8 * h;
        qf[ks] = (ks < 8) ? *(const bf16x8*)(Q1 + (rowb + qp) * ldq1 + d) : *(const bf16x8*)(Q2 + (rowb + qp) * ldq2 + (d - 128)); }
    unsigned sel = 0u;
    __syncthreads();
    if (MODE == 1) {
        if (qb <= 3) sel = (1u << qb) - 1u;
        else {
            LAS float* km = (LAS float*)(lds + ATT_KMOFF);
            for (int i = tid; i < 1024; i += NTHR) km[i] = kmean[i];
            __syncthreads();
            float g[7];
#pragma unroll
            for (int k = 0; k < 7; ++k) g[k] = 0.f;
#pragma unroll
            for (int dc = 0; dc < 8; ++dc) {
                const bf16x8 qv = *(const bf16x8*)(Q1 + (rowb + qp) * ldq1 + 64 * h + 8 * dc);
                float qx[8];
#pragma unroll
                for (int e = 0; e < 8; ++e) qx[e] = bf2f(qv[e]);
#pragma unroll
                for (int k = 0; k < 7; ++k) { const f32x4 a = *(const LAS f32x4*)(km + k * 128 + 64 * h + 8 * dc), c = *(const LAS f32x4*)(km + k * 128 + 64 * h + 8 * dc + 4);
                    g[k] += (qx[0] * a.x + qx[1] * a.y) + (qx[2] * a.z + qx[3] * a.w) + (qx[4] * c.x + qx[5] * c.y) + (qx[6] * c.z + qx[7] * c.w); }
            }
#pragma unroll
            for (int k = 0; k < 7; ++k) g[k] += __shfl_xor(g[k], 32);
#pragma unroll
            for (int r = 0; r < 3; ++r) { float best = -INFINITY; int bi = -1;
#pragma unroll
                for (int k = 0; k < 7; ++k) if (k < qb && !((sel >> k) & 1u) && g[k] > best) { best = g[k]; bi = k; }
                if (bi >= 0) sel |= 1u << bi; }
        }
    }
    float fl[16];
    if (MODE == 2) {
#pragma unroll
        for (int i = 0; i < 16; ++i) fl[i] = (((qp - 4 * h - ((i & 3) + 8 * (i >> 2))) & 15) == 0) ? 0.f : -INFINITY;
    }
    LAS float* dtab = (LAS float*)(lds + ATT_KMOFF + 4096);
    if (MODE == 2) { for (int i = tid; i < 2144; i += NTHR) dtab[i] = dil_lw(i - 96); }
    const int NT = 4 * (qb + 1);
    f32x16 o[4];
#pragma unroll
    for (int i = 0; i < 4; ++i) o[i] = (f32x16){0.f, 0.f, 0.f, 0.f, 0.f, 0.f, 0.f, 0.f, 0.f, 0.f, 0.f, 0.f, 0.f, 0.f, 0.f, 0.f};
    float mrun = -1e30f, lrun = 0.f;
    u32x4 kr0, kr1, kr2, vr0, vr1;
    const int srow0 = tid >> 4, sch = tid & 15, srow1 = srow0 + 32, rrow = tid >> 3, rch = tid & 7;
#define ATT_LOAD(t) do { const size_t kb_ = rowb + (size_t)(t) * 64; \
        kr0 = *(const u32x4*)(K1 + (kb_ + srow0) * ldk1 + 8 * sch); kr1 = *(const u32x4*)(K1 + (kb_ + srow1) * ldk1 + 8 * sch); \
        if (DQK == 192) kr2 = *(const u32x4*)(K2 + (kb_ + rrow) * ldk2 + 8 * rch); \
        vr0 = *(const u32x4*)(V + (kb_ + srow0) * ldv + 8 * sch); vr1 = *(const u32x4*)(V + (kb_ + srow1) * ldv + 8 * sch); } while (0)
#define ATT_STORE(bo) do { *(LAS u32x4*)(lds + (bo) + ATT_KOFF + srow0 * KP + 16 * sch) = kr0; *(LAS u32x4*)(lds + (bo) + ATT_KOFF + srow1 * KP + 16 * sch) = kr1; \
        if (DQK == 192) *(LAS u32x4*)(lds + (bo) + ATT_KOFF + rrow * KP + 256 + 16 * rch) = kr2; \
        *(LAS u32x4*)(lds + (bo) + ATT_VOFF + srow0 * ATT_VP + 16 * sch) = vr0; *(LAS u32x4*)(lds + (bo) + ATT_VOFF + srow1 * ATT_VP + 16 * sch) = vr1; } while (0)
    const LAS unsigned char* kbase = lds + ATT_KOFF + r32 * KP + 16 * h;
    const int i16 = lane & 15;
    const LAS unsigned char* vbase = lds + ATT_VOFF + (4 * h + (i16 >> 2)) * ATT_VP + (16 * ((lane >> 4) & 1) + 4 * (i16 & 3)) * 2;
    ATT_LOAD(0);
    ATT_STORE(0);
    ATT_LOAD(1);
    __syncthreads();
    for (int t = 0; t < NT; ++t) {
        const int bo = (t & 1) * ATT_BUF;
        bool act = (64 * t <= q0w + 31);
        bool allowed = true;
        const bool own = (MODE != 1) || ((t >> 2) == qb);
        if (MODE == 1 && !own) { allowed = ((sel >> (t >> 2)) & 1u) != 0u; act = act && (__ballot(allowed) != 0ull); }
        if (act) {
            const f32x16 z16 = (f32x16){0.f, 0.f, 0.f, 0.f, 0.f, 0.f, 0.f, 0.f, 0.f, 0.f, 0.f, 0.f, 0.f, 0.f, 0.f, 0.f};
            f32x16 s0 = z16, s1 = z16;
            const LAS unsigned char* kb = kbase + bo;
            bf16x8 ka[2][KB][2];
#pragma unroll
            for (int j = 0; j < KB; ++j) { ka[0][j][0] = *(const LAS bf16x8*)(kb + 32 * j); ka[0][j][1] = *(const LAS bf16x8*)(kb + 32 * KP + 32 * j); }
#pragma unroll
            for (int bt = 0; bt < NBT; ++bt) {
                if (bt + 1 < NBT) {
#pragma unroll
                    for (int j = 0; j < KB; ++j) { ka[(bt + 1) & 1][j][0] = *(const LAS bf16x8*)(kb + 32 * (KB * (bt + 1) + j)); ka[(bt + 1) & 1][j][1] = *(const LAS bf16x8*)(kb + 32 * KP + 32 * (KB * (bt + 1) + j)); }
                }
                SCHED_FENCE();
#pragma unroll
                for (int j = 0; j < KB; ++j) { s0 = MFMA32(ka[bt & 1][j][0], qf[KB * bt + j], s0); s1 = MFMA32(ka[bt & 1][j][1], qf[KB * bt + j], s1); }
                SCHED_FENCE();
            }
            const LAS unsigned char* vb = vbase + bo;
            s16x4 vf[2][4][2];
#pragma unroll
            for (int kk = 0; kk < 4; ++kk) { vf[0][kk][0] = vtr(vb + (16 * kk) * ATT_VP); vf[0][kk][1] = vtr(vb + (16 * kk + 8) * ATT_VP); }
            SCHED_FENCE();
            const int kp_base = 64 * t + 4 * h;
            const bool diag = (64 * t + 63 > q0w);
            float mnew;
            if (MODE == 2) {
                if (q0w - (64 * t + 63) > 512) {
#pragma unroll
                    for (int i = 0; i < 16; ++i) { s0[i] = __builtin_fmaf(s0[i], sc, fl[i]); s1[i] = __builtin_fmaf(s1[i], sc, fl[i]); }
                } else {
                    const LAS float* tp = dtab + (qp - 64 * t - 4 * h + 37);
#pragma unroll
                    for (int i = 0; i < 16; ++i) { const int ci = (i & 3) + 8 * (i >> 2);
                        s0[i] = __builtin_fmaf(s0[i], sc, tp[59 - ci]); s1[i] = __builtin_fmaf(s1[i], sc, tp[27 - ci]); }
                }
                float ma = max3(s0[0], s0[1], s1[0]), mb = max3(s0[2], s0[3], s1[1]); ma = max3(ma, s1[2], s1[3]);
#pragma unroll
                for (int i = 4; i < 16; i += 4) { ma = max3(ma, s0[i], s0[i + 1]); mb = max3(mb, s0[i + 2], s0[i + 3]); ma = max3(ma, s1[i], s1[i + 1]); mb = max3(mb, s1[i + 2], s1[i + 3]); }
                float mx = fmaxf(ma, mb); mx = fmaxf(mx, __shfl_xor(mx, 32));
                mnew = (__ballot(mx - mrun > ATT_THR) != 0ull) ? fmaxf(mrun, mx) : mrun;
#pragma unroll
                for (int i = 0; i < 16; ++i) { s0[i] = __builtin_amdgcn_exp2f(s0[i] - mnew); s1[i] = __builtin_amdgcn_exp2f(s1[i] - mnew); }
            } else {
                if (own && diag) {
#pragma unroll
                    for (int i = 0; i < 16; ++i) { const int kp0 = kp_base + (i & 3) + 8 * (i >> 2); if (kp0 > qp) s0[i] = -INFINITY; if (kp0 + 32 > qp) s1[i] = -INFINITY; }
                }
                if (MODE == 1 && !allowed) {
#pragma unroll
                    for (int i = 0; i < 16; ++i) { s0[i] = -INFINITY; s1[i] = -INFINITY; }
                }
                float ma = max3(s0[0], s0[1], s1[0]), mb = max3(s0[2], s0[3], s1[1]); ma = max3(ma, s1[2], s1[3]);
#pragma unroll
                for (int i = 4; i < 16; i += 4) { ma = max3(ma, s0[i], s0[i + 1]); mb = max3(mb, s0[i + 2], s0[i + 3]); ma = max3(ma, s1[i], s1[i + 1]); mb = max3(mb, s1[i + 2], s1[i + 3]); }
                float mx = fmaxf(ma, mb) * sc; mx = fmaxf(mx, __shfl_xor(mx, 32));
                mnew = (__ballot(mx - mrun > ATT_THR) != 0ull) ? fmaxf(mrun, mx) : mrun;
                const float nm = -mnew;
#pragma unroll
                for (int i = 0; i < 16; ++i) { s0[i] = __builtin_amdgcn_exp2f(__builtin_fmaf(s0[i], sc, nm)); s1[i] = __builtin_amdgcn_exp2f(__builtin_fmaf(s1[i], sc, nm)); }
            }
            float la = 0.f, lb = 0.f;
#pragma unroll
            for (int i = 0; i < 16; i += 2) { la += s0[i] + s1[i]; lb += s0[i + 1] + s1[i + 1]; }
            const float alpha = __builtin_amdgcn_exp2f(mrun - mnew);
            lrun = lrun * alpha + (la + lb);
            if (__ballot(mnew > mrun) != 0ull) {
#pragma unroll
                for (int db = 0; db < 4; ++db)
#pragma unroll
                    for (int i = 0; i < 16; ++i) o[db][i] *= alpha;
            }
            mrun = mnew;
            bf16x8 pf[2][2];
#pragma unroll
            for (int s = 0; s < 2; ++s) {
                u32x4 w0, w1;
                w0.x = cvtpk(s0[8 * s + 0], s0[8 * s + 1]); w0.y = cvtpk(s0[8 * s + 2], s0[8 * s + 3]); w0.z = cvtpk(s0[8 * s + 4], s0[8 * s + 5]); w0.w = cvtpk(s0[8 * s + 6], s0[8 * s + 7]);
                w1.x = cvtpk(s1[8 * s + 0], s1[8 * s + 1]); w1.y = cvtpk(s1[8 * s + 2], s1[8 * s + 3]); w1.z = cvtpk(s1[8 * s + 4], s1[8 * s + 5]); w1.w = cvtpk(s1[8 * s + 6], s1[8 * s + 7]);
                pf[0][s] = __builtin_bit_cast(bf16x8, w0); pf[1][s] = __builtin_bit_cast(bf16x8, w1);
            }
#pragma unroll
            for (int db = 0; db < 4; ++db) {
                if (db + 1 < 4) {
#pragma unroll
                    for (int kk = 0; kk < 4; ++kk) { vf[(db + 1) & 1][kk][0] = vtr(vb + (16 * kk) * ATT_VP + 64 * (db + 1)); vf[(db + 1) & 1][kk][1] = vtr(vb + (16 * kk + 8) * ATT_VP + 64 * (db + 1)); }
                }
                SCHED_FENCE();
#pragma unroll
                for (int kk = 0; kk < 4; ++kk) {
                    const s16x4 lo = vf[db & 1][kk][0], hi = vf[db & 1][kk][1];
                    const bf16x8 vv = (bf16x8){lo[0], lo[1], lo[2], lo[3], hi[0], hi[1], hi[2], hi[3]};
                    o[db] = MFMA32(vv, pf[kk >> 1][kk & 1], o[db]);
                }
                SCHED_FENCE();
            }
        }
        if (t + 1 < NT) { ATT_STORE(((t + 1) & 1) * ATT_BUF); if (t + 2 < NT) ATT_LOAD(t + 2); }
        __syncthreads();
    }
#undef ATT_LOAD
#undef ATT_STORE
    lrun += __shfl_xor(lrun, 32);
    const float inv = 1.0f / lrun;
    bf16* orow = O + (rowb + qp) * ldo + 8 * h;
#pragma unroll
    for (int db = 0; db < 4; ++db)
#pragma unroll
        for (int gp = 0; gp < 2; ++gp) {
            const int ge = 8 * gp, go = 8 * gp + 4;
            const unsigned x0 = cvtpk(o[db][ge + 0] * inv, o[db][ge + 1] * inv), x1 = cvtpk(o[db][ge + 2] * inv, o[db][ge + 3] * inv);
            const unsigned y0 = cvtpk(o[db][go + 0] * inv, o[db][go + 1] * inv), y1 = cvtpk(o[db][go + 2] * inv, o[db][go + 3] * inv);
            const auto sa = __builtin_amdgcn_permlane32_swap(x0, y0, false, false);
            const auto sb = __builtin_amdgcn_permlane32_swap(x1, y1, false, false);
            u32x4 w; w.x = sa[0]; w.y = sb[0]; w.z = sa[1]; w.w = sb[1];
            *(u32x4*)(orow + 32 * db + 16 * gp) = w;
        }
}

constexpr int O_GU1 = 0, O_D1 = O_GU1 + IT_GU, O_IN = O_D1 + IT_D, O_UQ = O_IN + IT_IN, O_UKV = O_UQ + IT_UQ, O_OUT = O_UKV + IT_UKV, O_GU2 = O_OUT + IT_OUT, O_D2 = O_GU2 + IT_GU;
static_assert(O_D2 + IT_D == IT_LAYER, "item list");
constexpr int CUTB = O_D2, CUT1 = CUTB + 2816, CUT2 = CUT1 + 2385, CUT3 = CUT2 + 6084, CUT4 = CUT3 + 6800, CUT5 = IT_LAYER + O_D2, CUTE = 2 * IT_LAYER;
static_assert(CUT1 >= IT_LAYER && CUT3 >= IT_LAYER + O_IN && CUT4 >= IT_LAYER + O_GU2 && CUT4 <= CUT5 && CUT5 == IT_LAYER + O_D2, "every matrix is copied before the phase that reads it");
struct Args;
__device__ __forceinline__ void convert_items(const float* const* in, unsigned char* ws, int lo, int hi, int rank, int nrank, int lane) {
    for (int it = lo + rank; it < hi; it += nrank) {
        const int l = it / IT_LAYER; int r = it - l * IT_LAYER;
        unsigned char* wl = ws + WS_W + (size_t)l * W_LAYER;
        const float* src; int NS, K, ND; bf16* dst; int kind;
        const float* src2 = nullptr; const float* gain = nullptr;
        if (r < IT_GU) { src = in[2] + (size_t)l * DM * DFF; src2 = in[3] + (size_t)l * DM * DFF; NS = DFF; K = DM; ND = 2 * DFF; dst = (bf16*)(wl + WO_GU1); kind = 1; gain = in[1] + (size_t)l * DM; }
        else if ((r -= IT_GU) < IT_D) { src = in[4] + (size_t)l * DFF * DM; NS = DM; K = DFF; ND = DM; dst = (bf16*)(wl + WO_D1); kind = 0; }
        else if ((r -= IT_D) < IT_IN) { src = in[6] + (size_t)l * DM * IN_W; NS = IN_W; K = DM; ND = NPROJ; dst = (bf16*)(wl + WO_IN); kind = 2; gain = in[5] + (size_t)l * DM; }
        else if ((r -= IT_IN) < IT_UQ) { src = in[9] + (size_t)l * 512 * 768; NS = 768; K = 512; ND = 768; dst = (bf16*)(wl + WO_UQ); kind = 3; gain = in[7] + (size_t)l * 512; }
        else if ((r -= IT_UQ) < IT_UKV) { src = in[10] + (size_t)l * 256 * 512; src2 = in[11] + (size_t)l * 256 * 512; NS = 512; K = 256; ND = 1024; dst = (bf16*)(wl + WO_UKV); kind = 4; gain = in[8] + (size_t)l * 256; }
        else if ((r -= IT_UKV) < IT_OUT) { src = in[12] + (size_t)l * DM * DM; NS = DM; K = DM; ND = DM; dst = (bf16*)(wl + WO_OUT); kind = 0; }
        else if ((r -= IT_OUT) < IT_GU) { src = in[14] + (size_t)l * DM * DFF; src2 = in[15] + (size_t)l * DM * DFF; NS = DFF; K = DM; ND = 2 * DFF; dst = (bf16*)(wl + WO_GU2); kind = 1; gain = in[13] + (size_t)l * DM; }
        else { r -= IT_GU; src = in[16] + (size_t)l * DFF * DM; NS = DM; K = DFF; ND = DM; dst = (bf16*)(wl + WO_D2); kind = 0; }
        const int nblk = ND / 32, kb = r / nblk, nb = r - kb * nblk, k0 = 128 * kb, n0 = 32 * nb;
        int sc_;
        if (kind == 0) sc_ = n0;
        else if (kind == 1) { const int t = n0 >> 8, bj = (n0 >> 7) & 1, c = n0 & 127; sc_ = 128 * t + c; if (bj) src = src2; }
        else if (kind == 2) sc_ = win_srccol(n0);
        else if (kind == 3) { if (n0 < 512) sc_ = (n0 >> 7) * 192 + (n0 & 127); else { const int w = n0 - 512, bj = w >> 7, c = w & 127; sc_ = (c >> 5) * 192 + 128 + 32 * bj; } }
        else { if (n0 < 512) sc_ = n0; else { sc_ = n0 - 512; src = src2; } }
        conv_item(sc_ >= 0 ? src + (size_t)k0 * NS + sc_ : nullptr, NS, K, dst + (size_t)n0 * K + k0, gain ? gain + k0 : nullptr, lane);
    }
}

#define XB_TMO      128
#define XB_XCNT(j)  (256  + 64 * (j))
#define XB_XSUB(j)  (1280 + 64 * (j))
#define XB_XGEN(j)  (2304 + 64 * (j))
#define XB_TOP      3328
#define XB_TOPGEN   3392
#define XCD_BAR_WORDS 3456
#define XB_SPIN_CAP (1u << 18)

__device__ __forceinline__ unsigned xb_ld(unsigned* p)              { return __hip_atomic_load(p, __ATOMIC_RELAXED, __HIP_MEMORY_SCOPE_AGENT); }
__device__ __forceinline__ unsigned xb_add(unsigned* p, unsigned v) { return __hip_atomic_fetch_add(p, v, __ATOMIC_RELAXED, __HIP_MEMORY_SCOPE_AGENT); }
__device__ __forceinline__ unsigned xb_xcc_id() { return (unsigned)__builtin_amdgcn_s_getreg((3 << 11) | 20) & 0xFu; }
#define XB_SPIN(cond, bar) do { unsigned _sp = 0; while (cond) { __builtin_amdgcn_s_sleep(1); \
    if ((++_sp & 255u) == 0u) { if (xb_ld(&(bar)[XB_TMO])) break; if (_sp > XB_SPIN_CAP) { atomicAdd(&(bar)[XB_TMO], 1u); break; } } } } while (0)

struct XcdBarrier {
    unsigned* bar; unsigned x;
    volatile LAS unsigned* st;
};

__device__ __forceinline__ XcdBarrier xcd_barrier_post(unsigned* bar, volatile LAS unsigned* st) {
    XcdBarrier b; b.bar = bar; b.x = xb_xcc_id(); b.st = st;
    if (threadIdx.x == 0) (void)xb_add(&bar[XB_XCNT(b.x)], 1u);
    return b;
}
__device__ __forceinline__ void xcd_barrier_complete(unsigned* bar, unsigned x, unsigned& nloc, unsigned& nx) {
    const unsigned G = gridDim.x * gridDim.y * gridDim.z;
    unsigned sum, cnt, mine, sp = 0u;
    for (;;) {
        sum = 0u; cnt = 0u; mine = 0u;
#pragma unroll
        for (unsigned j = 0; j < 16; ++j) { const unsigned c = xb_ld(&bar[XB_XCNT(j)]); sum += c; cnt += (c > 0u) ? 1u : 0u; mine = (j == x) ? c : mine; }
        if (sum == G) break;
        __builtin_amdgcn_s_sleep(1);
        if ((++sp & 255u) == 0u) { if (xb_ld(&bar[XB_TMO])) break; if (sp > XB_SPIN_CAP) { atomicAdd(&bar[XB_TMO], 1u); break; } }
    }
    nloc = mine > 0u ? mine : 1u; nx = cnt > 0u ? cnt : 1u;
}

__device__ __forceinline__ void xcd_barrier(const XcdBarrier& b) {
    asm volatile("s_waitcnt vmcnt(0)" ::: "memory");
    __syncthreads();
    if (threadIdx.x == 0) {
        unsigned* bar = b.bar;
        __builtin_amdgcn_s_waitcnt(0);
        unsigned nloc = b.st[0], nx = b.st[1];
        if (nloc == 0u) { xcd_barrier_complete(bar, b.x, nloc, nx); b.st[0] = nloc; b.st[1] = nx; }
        const unsigned old = xb_add(&bar[XB_XSUB(b.x)], 1u);
        const unsigned gen = old / nloc;
        if (old + 1u == (gen + 1u) * nloc) {
            __builtin_amdgcn_fence(__ATOMIC_RELEASE, "agent");
            asm volatile("s_waitcnt vmcnt(0)" ::: "memory");
            const unsigned og = xb_add(&bar[XB_TOP], 1u);
            const unsigned tg = og / nx;
            if (og + 1u == (tg + 1u) * nx) xb_add(&bar[XB_TOPGEN], 1u);
            else XB_SPIN(xb_ld(&bar[XB_TOPGEN]) == tg, bar);
            __builtin_amdgcn_fence(__ATOMIC_ACQUIRE, "agent");
            xb_add(&bar[XB_XGEN(b.x)], 1u);
            asm volatile("s_waitcnt vmcnt(0)" ::: "memory");
        } else {
            XB_SPIN(xb_ld(&bar[XB_XGEN(b.x)]) == gen, bar);
            __builtin_amdgcn_fence(__ATOMIC_ACQUIRE, "agent");
            asm volatile("s_waitcnt vmcnt(0)" ::: "memory");
        }
    }
    __syncthreads();
}

struct Args { const float* in[18]; float* out; unsigned char* ws; int ph_lo, ph_hi; };
template <int PH> __device__ __forceinline__ void run_phase(const Args& args, LAS unsigned char* lds) {
    const int G = gridDim.x, bid = blockIdx.x, NGW = G * NWAVES;
    unsigned char* ws = args.ws;
    float* X = (float*)(ws + WS_X); bf16* XB = (bf16*)(ws + WS_XB); bf16* HP = (bf16*)(ws + WS_HP); bf16* CAT = (bf16*)(ws + WS_CAT);
    bf16* QM = (bf16*)(ws + WS_QM); bf16* KV = (bf16*)(ws + WS_KV);
    float* STAT = (float*)(ws + WS_STAT);
    float* COSH = (float*)(ws + WS_TAB); float* SINH = COSH + 2048 * 64; float* COSR = SINH + 2048 * 64; float* SINR = COSR + 2048 * 32;
    int tid_l = threadIdx.x; asm volatile("" : "+v"(tid_l));
    const int tid = tid_l, lane = tid & 63, wave = __builtin_amdgcn_readfirstlane(tid >> 6), gw = bid * NWAVES + wave;
    constexpr int ph = PH;
    if constexpr (ph == 0) {
        convert_items(args.in, ws, 0, O_D1, gw, NGW, lane); convert_items(args.in, ws, O_OUT, CUTB, gw, NGW, lane);
        for (int idx = bid * NTHR + tid; idx < 2048 * 96; idx += G * NTHR) {
            int pos, j, dim; float* ct; float* st;
            if (idx < 2048 * 64) { pos = idx >> 6; j = idx & 63; dim = 128; ct = COSH + idx; st = SINH + idx; }
            else { const int i2 = idx - 2048 * 64; pos = i2 >> 5; j = i2 & 31; dim = 64; ct = COSR + i2; st = SINR + i2; }
            const float e = -(float)(2 * j) / (float)dim;
            const float invf = (float)exp((double)e * 9.21034037197618273607);
            const float ang = (float)pos * invf;
            float s, c; sincos_d((double)ang, s, c);
            *ct = c; *st = s;
        }
        for (int idx = MROWS + bid * NTHR + tid; idx < ST_TOTAL; idx += G * NTHR) STAT[idx] = 0.f;
        for (int m = gw; m < MROWS; m += NGW) {
            const f32x4* xr = (const f32x4*)(args.in[0] + (size_t)m * DM) + 2 * lane;
            u32x4* o = (u32x4*)(XB + (size_t)m * DM) + lane;
            float s = 0.f;
#pragma unroll
            for (int j = 0; j < 4; ++j) { const f32x4 va = __builtin_nontemporal_load(xr + 128 * j), vb = __builtin_nontemporal_load(xr + 128 * j + 1);
                s += ((va.x * va.x + va.y * va.y) + (va.z * va.z + va.w * va.w)) + ((vb.x * vb.x + vb.y * vb.y) + (vb.z * vb.z + vb.w * vb.w));
                u32x4 w; w.x = pk2(va.x, va.y); w.y = pk2(va.z, va.w); w.z = pk2(vb.x, vb.y); w.w = pk2(vb.z, vb.w); o[64 * j] = w; }
            s = wave_sum(s);
            if (lane == 0) STAT[ST_SS + m] = s;
        }
    } else if constexpr (ph == NPHASE - 1) {
        const float* g = args.in[17]; const float* ssf = STAT + ST_SS + 6 * MROWS;
        f32x4 gv[8];
#pragma unroll
        for (int j = 0; j < 8; ++j) gv[j] = *(const f32x4*)(g + 4 * lane + 256 * j);
        for (int m = gw; m < MROWS; m += NGW) {
            const f32x4* xr = (const f32x4*)(X + (size_t)m * DM) + lane; f32x4* o = (f32x4*)(args.out + (size_t)m * DM) + lane;
            const float rstd = 1.0f / sqrtf(ssf[m] * (1.0f / DM) + EPS);
#pragma unroll
            for (int j = 0; j < 8; ++j) o[64 * j] = (xr[64 * j] * rstd) * gv[j];
        }
    } else {
        constexpr int l = (ph - 1) / 8, k = (ph - 1) % 8;
        unsigned char* wl = ws + WS_W + (size_t)l * W_LAYER;
        float* SS = STAT + ST_SS + (size_t)(3 * l) * MROWS;
        if constexpr (k == 0 || k == 6) {
            pg8::Gemm g{XB, (const bf16*)(wl + (k == 0 ? WO_GU1 : WO_GU2)), MROWS, 2 * DFF, DM, DM}; pg8::StaticOrder S; S.init(MROWS, 2 * DFF, G, bid);
            pg8::EpiSwiglu E{HP, DFF, SS + (k == 0 ? 0 : 2) * MROWS, 1.0f / DM};
            pg8::gemm_phase<pg8::EpiSwiglu, pg8::StaticOrder, true, true>(lds, g, S, E);
            { constexpr int nwg = (MROWS / 256) * (2 * DFF / 256); const int rem = nwg % G;
              constexpr int lo_ = (l == 0 && k == 0) ? CUTB : (l == 0 && k == 6) ? CUT2 : (l == 1 && k == 0) ? CUT3 : CUT5;
              constexpr int hi_ = (l == 0 && k == 0) ? CUT1 : (l == 0 && k == 6) ? CUT3 : (l == 1 && k == 0) ? CUT4 : CUTE;
              if (rem > 0 && bid >= rem) { if constexpr (l == 0 && k == 0) convert_items(args.in, ws, O_D1, O_OUT, (bid - rem) * NWAVES + wave, (G - rem) * NWAVES, lane);
                  convert_items(args.in, ws, lo_, hi_, (bid - rem) * NWAVES + wave, (G - rem) * NWAVES, lane); } }
        } else if constexpr (k == 1 || k == 5 || k == 7) {
            const bf16* A = (k == 5) ? CAT : HP; const int K = (k == 5) ? DM : DFF;
            const bf16* Bt = (const bf16*)(wl + (k == 1 ? WO_D1 : k == 5 ? WO_OUT : WO_D2));
            pg8::Gemm g{A, Bt, MROWS, DM, K, K}; pg8::StaticOrder S; S.init(MROWS, DM, G, bid);
            pg8::EpiResid E{(l == 0 && k == 1) ? args.in[0] : X, X, XB, SS + (k == 1 ? 1 : k == 5 ? 2 : 3) * MROWS, DM, (k == 5) ? 1.0f : 0.5f, (k == 5) ? 1.0f : 2.0f};
            pg8::gemm_phase<pg8::EpiResid, pg8::StaticOrder, true, true>(lds, g, S, E);
        } else if constexpr (k == 2) {
            pg8::Gemm g{XB, (const bf16*)(wl + WO_IN), MROWS, NPROJ, DM, DM}; pg8::StaticOrder S; S.init(MROWS, NPROJ, G, bid);
            pg8::EpiProj<true> E{HP, NPROJ, 0, 12, 21, COSH, SINH, COSR, SINR, SS + 1 * MROWS, 1.0f / DM, STAT + ST_SSQ + l * MROWS, STAT + ST_SSKV + l * MROWS, STAT + ST_KSUM + l * 16384};
            pg8::gemm_phase<pg8::EpiProj<true>, pg8::StaticOrder, true, true>(lds, g, S, E);
            { constexpr int nwg = (MROWS / 256) * (NPROJ / 256); const int rem = nwg % G;
              constexpr int lo_ = (l == 0 ? CUT1 : CUT4), hi_ = (l == 0 ? CUT2 : CUT5);
              if (rem > 0 && bid >= rem) convert_items(args.in, ws, lo_, hi_, (bid - rem) * NWAVES + wave, (G - rem) * NWAVES, lane); }
        } else if constexpr (k == 3) {
            for (int gi = 0; gi < 2; ++gi) {
                const int N = gi ? 1024 : 768, K = gi ? 256 : 512;
                pg8::Gemm g{HP + (gi ? P_CKV : P_CQ), (const bf16*)(wl + (gi ? WO_UKV : WO_UQ)), MROWS, N, K, NPROJ};
                pg8::StaticOrder S; S.init(MROWS, N, G, gi ? (bid + G - (96 % G)) % G : bid);
                pg8::EpiProj<false> E{gi ? KV : QM, N, 0, 0, gi ? -1 : 2, COSH, SINH, COSR, SINR, STAT + (gi ? ST_SSKV : ST_SSQ) + l * MROWS, gi ? 1.0f / 256.0f : 1.0f / 512.0f, nullptr, nullptr, nullptr};
                pg8::gemm_phase<pg8::EpiProj<false>, pg8::StaticOrder, true, true>(lds, g, S, E);
            }
        } else if constexpr (k == 4) {
            const float L2E = 1.4426950408889634f;
            const float sc_mla = 0.07216878364870322f * L2E, sc_h = 0.08838834764831845f * L2E;
            const float* KSUM = STAT + ST_KSUM + l * 16384;
            unsigned* wq = (unsigned*)(STAT + ST_WQ + 64 * l);
            LAS unsigned* wslot = (LAS unsigned*)(lds + 131072 + 1024);
            for (;;) {
                __syncthreads();
                if (tid == 0) wslot[0] = __hip_atomic_fetch_add(wq, 1u, __ATOMIC_RELAXED, __HIP_MEMORY_SCOPE_AGENT);
                __syncthreads();
                const unsigned u = wslot[0];
                if (u >= 512u) break;
                const int qb = 7 - (int)(u >> 6), idx = (int)(u & 63);
                if (idx < 16) { const int b = idx >> 2, hd = idx & 3;
                    attn_unit<192, 0>(lds, qb, b, QM + hd * 128, 768, QM + 512 + hd * 64, 768, KV + hd * 128, 1024, HP + P_KR, NPROJ, KV + 512 + hd * 128, 1024, CAT + hd * 128, DM, sc_mla, nullptr);
                } else if (idx < 48) { const int j = idx - 16, b = j >> 3, hd = j & 7;
                    attn_unit<128, 2>(lds, qb, b, HP + PQ_DIL + hd * 128, NPROJ, nullptr, 0, HP + PK_DIL + hd * 128, NPROJ, nullptr, 0, HP + PV_DIL + hd * 128, NPROJ, CAT + 1024 + hd * 128, DM, sc_h, nullptr);
                } else { const int j = idx - 48, b = j >> 2, hd = j & 3;
                    attn_unit<128, 1>(lds, qb, b, HP + PQ_MOBA + hd * 128, NPROJ, nullptr, 0, HP + PK_MOBA + hd * 128, NPROJ, nullptr, 0, HP + PV_MOBA + hd * 128, NPROJ, CAT + 512 + hd * 128, DM, sc_h, KSUM + (size_t)j * 1024);
                }
            }
            __syncthreads();
        }
    }
}
__global__ void __launch_bounds__(NTHR, 2) fwd_kernel(Args args) {
    extern __shared__ __attribute__((aligned(16))) unsigned char lds_raw[];
    LAS unsigned char* lds = (LAS unsigned char*)lds_raw;
    const int lo = args.ph_lo, hi = args.ph_hi;
    volatile LAS unsigned* misc = (volatile LAS unsigned*)(lds + 131072 + 512);
    if (threadIdx.x < 2) misc[threadIdx.x] = 0u;
    __syncthreads();
    XcdBarrier bar = xcd_barrier_post((unsigned*)(args.ws + WS_BAR), misc);
#define PHASE(k) if (lo <= (k) && (k) < hi) { run_phase<k>(args, lds); if ((k) + 1 < hi) { if (lo < 0) cg::this_grid().sync(); else xcd_barrier(bar); } }
    PHASE(0) PHASE(1) PHASE(2) PHASE(3) PHASE(4) PHASE(5) PHASE(6) PHASE(7) PHASE(8) PHASE(9) PHASE(10) PHASE(11) PHASE(12) PHASE(13) PHASE(14) PHASE(15) PHASE(16) PHASE(17)
#undef PHASE
    static_assert(NPHASE == 18, "phase list");
}

extern "C" void kernel_launch(void* const* d_in, const int* in_sizes, int n_in, void* d_out, int out_size, void* d_ws, size_t ws_size, hipStream_t stream) {
    static int grid = 0;
    if (grid == 0) {
        if (n_in != 18 || in_sizes[0] != MROWS * DM || out_size != MROWS * DM || ws_size < WS_END) {
            fprintf(stderr, "kernel_launch: unexpected shapes (n_in %d, in0 %d, out %d, ws %zu < %zu)\n", n_in, n_in > 0 ? in_sizes[0] : -1, out_size, ws_size, (size_t)WS_END); grid = -1; return; }
        int dev = 0, cus = 0, per_cu = 0;
        (void)hipGetDevice(&dev); (void)hipDeviceGetAttribute(&cus, hipDeviceAttributeMultiprocessorCount, dev);
        if (hipFuncSetAttribute((const void*)fwd_kernel, hipFuncAttributeMaxDynamicSharedMemorySize, LDS_BYTES) != hipSuccess) { fprintf(stderr, "kernel_launch: hipFuncSetAttribute failed\n"); grid = -1; return; }
        if (hipOccupancyMaxActiveBlocksPerMultiprocessor(&per_cu, (const void*)fwd_kernel, NTHR, LDS_BYTES) != hipSuccess || per_cu < 1) { fprintf(stderr, "kernel_launch: occupancy query says %d\n", per_cu); per_cu = 1; }
        (void)hipGetLastError();
        grid = cus * per_cu;
        if (grid <= 0) grid = 256;
    }
    if (grid < 0) return;
    Args a{};
    for (int i = 0; i < 18; ++i) a.in[i] = (const float*)d_in[i];
    a.out = (float*)d_out; a.ws = (unsigned char*)d_ws;
#if MK_COOP
    a.ph_lo = 0; a.ph_hi = NPHASE;
    (void)hipMemsetAsync((unsigned char*)d_ws + WS_BAR, 0, BAR_BYTES, stream);
    void* kargs[] = {&a};
    hipError_t e = hipLaunchCooperativeKernel((const void*)fwd_kernel, dim3(grid), dim3(NTHR), kargs, LDS_BYTES, stream);
    if (e != hipSuccess) fprintf(stderr, "kernel_launch: cooperative launch failed: %s (grid %d)\n", hipGetErrorString(e), grid);
#else
    for (int ph = 0; ph < NPHASE; ++ph) { a.ph_lo = ph; a.ph_hi = ph + 1; hipLaunchKernelGGL(fwd_kernel, dim3(grid), dim3(NTHR), LDS_BYTES, stream, a); }
#endif
}
```
